# Optimizing an MI355X kernel written in HIP

```python
import math
import jax
import jax.numpy as jnp
from jax import lax
import numpy as np

D_MODEL = 2048
BATCH = 4
SEQ = 4096
DEPTH = 4

GRID_W = 64
CTX_LEN = 256
N_BRANCH = 4
BRANCH_W = D_MODEL // 4
FN_GROUPS = 4
FN_GW = BRANCH_W // FN_GROUPS
DN_HEADS = 4
DN_DK = BRANCH_W // DN_HEADS
DN_DV = BRANCH_W // DN_HEADS
DN_CONV = 3
DN_CHUNK = 64
HG_HEADS = 4
HG_DK = BRANCH_W // HG_HEADS
HG_DV = BRANCH_W // HG_HEADS
HG_CHUNK = 64
DA_HEADS = 4
DA_DH = BRANCH_W // (2 * DA_HEADS)
DA_DV = 2 * DA_DH
Q_BLOCK = 128
ROPE_THETA = 10000.0
EPS = 1e-6

IN_LAYOUT = (
    ('fn_u', BRANCH_W), ('fn_z', BRANCH_W),
    ('dn_q', BRANCH_W), ('dn_k', BRANCH_W), ('dn_v', BRANCH_W), ('dn_z', BRANCH_W),
    ('dn_a', 2 * DN_HEADS), ('dn_b', 2 * DN_HEADS),
    ('hg_q', BRANCH_W), ('hg_f', 2 * BRANCH_W), ('hg_i', BRANCH_W), ('hg_z', BRANCH_W),
    ('da_q', BRANCH_W), ('da_k', BRANCH_W), ('da_v', BRANCH_W), ('da_z', BRANCH_W),
    ('gate', N_BRANCH * D_MODEL),
)
IN_W = sum(w for _, w in IN_LAYOUT)

kernel_name = 'hybrid_parallel_gated_diffusion_trunk'


def _rms(x, g):
    xf = x.astype(jnp.float32)
    y = xf * lax.rsqrt(jnp.mean(xf * xf, axis=-1, keepdims=True) + EPS)
    return (y * g.astype(jnp.float32)).astype(x.dtype)


def _head_rms(o, g, dtype):
    y = o * lax.rsqrt(jnp.mean(o * o, axis=-1, keepdims=True) + EPS) * g.astype(jnp.float32)
    return y.reshape(o.shape[:2] + (-1,)).astype(dtype)


def _l2n(x):
    return x * lax.rsqrt(jnp.sum(x * x, axis=-1, keepdims=True) + EPS)


def _split_proj(p):
    out, off = {}, 0
    for name, w in IN_LAYOUT:
        out[name] = p[..., off:off + w]
        off += w
    return out


def _stream_in(x, mod, norm_g, w_in):
    shift, scale, gate = jnp.split(mod, 3, axis=-1)
    h = _rms(x, norm_g) * (1.0 + scale) + shift
    return _split_proj(h @ w_in), gate


def _to_chunks(a, c):
    b, t = a.shape[:2]
    a = a.reshape((b, t // c, c) + a.shape[2:])
    return jnp.moveaxis(a, (1, 3), (0, 2))


def _from_chunks(a):
    a = jnp.moveaxis(a, (0, 2), (1, 3))
    return a.reshape((a.shape[0], -1) + a.shape[3:])


def _fourier(u, w, b):
    bsz, t, _ = u.shape
    ug = u.astype(jnp.float32).reshape(bsz, t, FN_GROUPS, FN_GW)
    f = jnp.fft.fft2(ug, axes=(1, 3), norm='ortho').real
    return f.reshape(bsz, t, BRANCH_W).astype(u.dtype) @ w + b


def _short_conv(u, w):
    pad = DN_CONV // 2
    t = u.shape[1]
    up = jnp.pad(u, ((0, 0), (pad, pad), (0, 0)))
    y = sum(up[:, k:k + t] * w[k] for k in range(DN_CONV))
    return jax.nn.silu(y)


def _dn_prep(p, conv_w, a_log, dt_bias):
    bsz, t, _ = p['dn_q'].shape
    qkv = _short_conv(jnp.concatenate([p['dn_q'], p['dn_k'], p['dn_v']], axis=-1), conv_w)
    q, k, v = jnp.split(qkv.astype(jnp.float32), 3, axis=-1)
    q = _l2n(q.reshape(bsz, t, DN_HEADS, DN_DK)) * DN_DK ** -0.5
    k = _l2n(k.reshape(bsz, t, DN_HEADS, DN_DK))
    v = v.reshape(bsz, t, DN_HEADS, DN_DV)
    a = p['dn_a'].astype(jnp.float32).reshape(bsz, t, 2, DN_HEADS)
    g = -jnp.exp(a_log.astype(jnp.float32)) * jax.nn.softplus(a + dt_bias.astype(jnp.float32))
    beta = jax.nn.sigmoid(p['dn_b'].astype(jnp.float32).reshape(bsz, t, 2, DN_HEADS))
    return q, k, v, g, beta


def _delta_chunked(q, k, v, g, beta, s0):
    c = DN_CHUNK
    q, k, v = _to_chunks(q, c), _to_chunks(k, c), _to_chunks(v, c)
    g, beta = _to_chunks(g, c), _to_chunks(beta, c)
    gc = jnp.cumsum(g, axis=-1)
    idx = jnp.arange(c)
    incl = idx[:, None] >= idx[None, :]
    strict = idx[:, None] > idx[None, :]
    decay = jnp.exp(jnp.where(incl, gc[..., :, None] - gc[..., None, :], -jnp.inf))
    kb = k * beta[..., None]
    a_kk = jnp.where(strict, jnp.einsum('nbhid,nbhjd->nbhij', kb, k) * decay, 0.0)
    eye = jnp.eye(c, dtype=a_kk.dtype)
    t_inv = lax.linalg.triangular_solve(a_kk + eye, jnp.broadcast_to(eye, a_kk.shape),
                                        left_side=True, lower=True, unit_diagonal=True)
    u = t_inv @ (v * beta[..., None])
    w = t_inv @ (kb * jnp.exp(gc)[..., None])
    a_qk = jnp.where(incl, jnp.einsum('nbhid,nbhjd->nbhij', q, k) * decay, 0.0)
    q_dec = q * jnp.exp(gc)[..., None]
    k_dec = k * jnp.exp(gc[..., -1:] - gc)[..., None]
    g_last = jnp.exp(gc[..., -1])[..., None, None]

    def step(s, xs):
        u_n, w_n, aqk_n, qd_n, kd_n, gl_n = xs
        v_new = u_n - w_n @ s
        o_n = qd_n @ s + aqk_n @ v_new
        s = s * gl_n + jnp.einsum('bhcd,bhce->bhde', kd_n, v_new)
        return s, o_n

    s, o = lax.scan(step, s0, (u, w, a_qk, q_dec, k_dec, g_last))
    return _from_chunks(o), s


def _dn_bidir(q, k, v, g, beta, s_f, s_b):
    flip = lambda a: jnp.flip(a, axis=1)
    o_f, s_f = _delta_chunked(q, k, v, g[:, :, 0], beta[:, :, 0], s_f)
    o_b, s_b = _delta_chunked(flip(q), flip(k), flip(v), flip(g[:, :, 1]), flip(beta[:, :, 1]), s_b)
    return o_f + flip(o_b), s_f, s_b


def _hg_prep(p, lb):
    bsz, t, _ = p['hg_q'].shape
    q = jax.nn.silu(p['hg_q'].astype(jnp.float32)).reshape(bsz, t, HG_HEADS, HG_DK)
    f = p['hg_f'].astype(jnp.float32).reshape(bsz, t, 2, HG_HEADS * HG_DK)
    log_f = jnp.logaddexp(jnp.log(lb), jnp.log1p(-lb) + jax.nn.log_sigmoid(f))
    k = (1.0 - lb) * jax.nn.sigmoid(-f)
    v = p['hg_i'].astype(jnp.float32).reshape(bsz, t, HG_HEADS, HG_DV)
    return (q, k.reshape(bsz, t, 2, HG_HEADS, HG_DK), v,
            log_f.reshape(bsz, t, 2, HG_HEADS, HG_DK))


def _hgrn2_chunked(q, k, v, log_f, s0):
    c = HG_CHUNK
    q, k, v, log_f = (_to_chunks(a, c) for a in (q, k, v, log_f))
    gc = jnp.cumsum(log_f, axis=-2)
    idx = jnp.arange(c)
    incl = idx[:, None] >= idx[None, :]

    def step(s, xs):
        q_n, k_n, v_n, g_n = xs
        diff = g_n[..., :, None, :] - g_n[..., None, :, :]
        dec = jnp.exp(jnp.where(incl[:, :, None], diff, -jnp.inf))
        a_qk = jnp.einsum('bhid,bhjd,bhijd->bhij', q_n, k_n, dec)
        o_n = (q_n * jnp.exp(g_n)) @ s + a_qk @ v_n
        g_last = g_n[..., -1:, :]
        s = (jnp.exp(g_last[..., 0, :])[..., None] * s
             + jnp.einsum('bhcd,bhce->bhde', k_n * jnp.exp(g_last - g_n), v_n))
        return s, o_n

    s, o = lax.scan(step, s0, (q, k, v, gc))
    return _from_chunks(o), s


def _hg_bidir(q, k, v, log_f, s_f, s_b):
    flip = lambda a: jnp.flip(a, axis=1)
    o_f, s_f = _hgrn2_chunked(q, k[:, :, 0], v, log_f[:, :, 0], s_f)
    o_b, s_b = _hgrn2_chunked(flip(q), flip(k[:, :, 1]), flip(v), flip(log_f[:, :, 1]), s_b)
    return o_f + flip(o_b), s_f, s_b


def _axial_angles(t):
    rows = t // GRID_W
    pos = jnp.arange(rows * GRID_W)
    row = (pos // GRID_W).astype(jnp.float32)
    col = (pos % GRID_W).astype(jnp.float32)
    n = DA_DH // 4
    inv = ROPE_THETA ** (-jnp.arange(n, dtype=jnp.float32) / n)
    return row[:, None] * inv, col[:, None] * inv


def _rope_half(x, ang):
    x1, x2 = jnp.split(x, 2, axis=-1)
    cos = jnp.cos(ang)[None, :, None, None, :].astype(x.dtype)
    sin = jnp.sin(ang)[None, :, None, None, :].astype(x.dtype)
    return jnp.concatenate([x1 * cos - x2 * sin, x2 * cos + x1 * sin], axis=-1)


def _axial_rope(x, ang_r, ang_c):
    half = DA_DH // 2
    return jnp.concatenate([_rope_half(x[..., :half], ang_r), _rope_half(x[..., half:], ang_c)], axis=-1)


def _da_prep(p):
    bsz, t, _ = p['da_q'].shape
    q = p['da_q'].reshape(bsz, t, DA_HEADS, 2, DA_DH)
    k = p['da_k'].reshape(bsz, t, DA_HEADS, 2, DA_DH)
    v = p['da_v'].reshape(bsz, t, DA_HEADS, DA_DV)
    return q, k, v


def _diff_block(qb, k, v, lam):
    s = jnp.einsum('bqhmd,bkhmd->bhmqk', qb, k).astype(jnp.float32) * DA_DH ** -0.5
    p = jax.nn.softmax(s, axis=-1)
    a = p[:, :, 0] - lam * p[:, :, 1]
    return jnp.einsum('bhqk,bkhd->bqhd', a.astype(v.dtype), v)


def _diff_latent(q, k_all, v_all, lam):
    bsz, t = q.shape[:2]
    qb = jnp.moveaxis(q.reshape((bsz, t // Q_BLOCK, Q_BLOCK) + q.shape[2:]), 1, 0)
    o = lax.map(lambda blk: _diff_block(blk, k_all, v_all, lam), qb)
    return jnp.moveaxis(o, 0, 1).reshape(bsz, t, DA_HEADS, DA_DV)


def _branches(p, o_dn, o_hg, o_da, fn_w, fn_b, dn_norm, hg_norm, da_norm, lam_init):
    dt = p['fn_u'].dtype
    y_fn = _fourier(p['fn_u'], fn_w, fn_b) * jax.nn.silu(p['fn_z'])
    y_dn = _head_rms(o_dn, dn_norm, dt) * jax.nn.silu(p['dn_z'])
    y_hg = _head_rms(o_hg, hg_norm, dt) * jax.nn.silu(p['hg_z'])
    y_da = _head_rms(o_da.astype(jnp.float32), da_norm, dt) * (1.0 - lam_init) * jax.nn.silu(p['da_z'])
    return (y_fn, y_dn, y_hg, y_da)


def _merge(gate_logits, ys, w_branch, w_out):
    bsz, t, _ = gate_logits.shape
    g = jax.nn.sigmoid(gate_logits).reshape(bsz, t, N_BRANCH, D_MODEL)
    y = sum(g[:, :, n] * (ys[n] @ w_branch[n]) for n in range(N_BRANCH))
    return y @ w_out


def setup_inputs(seed: int = 0) -> dict:
    key = jax.random.key(seed)
    ks = jax.random.split(key, 24)
    f32 = jnp.float32
    nrm = lambda k, shape, scale: jax.random.normal(k, shape, f32) * scale
    x = nrm(ks[0], (BATCH, SEQ, D_MODEL), 1.0)
    c = nrm(ks[1], (BATCH, D_MODEL), 1.0)
    ctx = nrm(ks[2], (BATCH, CTX_LEN, D_MODEL), 1.0)
    c_ctx = nrm(ks[3], (D_MODEL,), 1.0)
    norm_g = 1.0 + nrm(ks[4], (DEPTH, D_MODEL), 0.02)
    w_ada = nrm(ks[5], (DEPTH, D_MODEL, 3 * D_MODEL), 0.5 * D_MODEL ** -0.5)
    b_ada = nrm(ks[6], (DEPTH, 3 * D_MODEL), 0.02)
    w_in = nrm(ks[7], (DEPTH, D_MODEL, IN_W), D_MODEL ** -0.5)
    fn_w = nrm(ks[8], (DEPTH, BRANCH_W, BRANCH_W), BRANCH_W ** -0.5)
    fn_b = nrm(ks[9], (DEPTH, BRANCH_W), 0.02)
    dn_conv = nrm(ks[10], (DEPTH, DN_CONV, 3 * BRANCH_W), DN_CONV ** -0.5)
    dn_a_log = jnp.log(jax.random.uniform(ks[11], (DEPTH, 2, DN_HEADS), f32, 1.0, 16.0))
    dt0 = jnp.exp(jax.random.uniform(ks[12], (DEPTH, 2, DN_HEADS), f32, math.log(1e-3), math.log(1e-1)))
    dn_dt_bias = dt0 + jnp.log(-jnp.expm1(-dt0))
    dn_norm = 1.0 + nrm(ks[13], (DEPTH, DN_DV), 0.02)
    hg_lb_logits = nrm(ks[14], (2, DEPTH, HG_HEADS * HG_DK), 0.5)
    hg_norm = 1.0 + nrm(ks[15], (DEPTH, HG_DV), 0.02)
    da_lambda = nrm(ks[16], (DEPTH, 4, DA_DH), 0.1)
    da_norm = 1.0 + nrm(ks[17], (DEPTH, DA_DV), 0.02)
    w_branch = nrm(ks[18], (DEPTH, N_BRANCH, BRANCH_W, D_MODEL), BRANCH_W ** -0.5)
    w_out = nrm(ks[19], (DEPTH, D_MODEL, D_MODEL), D_MODEL ** -0.5)
    final_g = 1.0 + nrm(ks[20], (D_MODEL,), 0.02)
    return {'x': x, 'c': c, 'ctx': ctx, 'c_ctx': c_ctx, 'norm_g': norm_g, 'w_ada': w_ada,
            'b_ada': b_ada, 'w_in': w_in, 'fn_w': fn_w, 'fn_b': fn_b, 'dn_conv': dn_conv,
            'dn_a_log': dn_a_log, 'dn_dt_bias': dn_dt_bias, 'dn_norm': dn_norm,
            'hg_lb_logits': hg_lb_logits, 'hg_norm': hg_norm, 'da_lambda': da_lambda,
            'da_norm': da_norm, 'w_branch': w_branch, 'w_out': w_out, 'final_g': final_g}


def reference(x, c, ctx, c_ctx, norm_g, w_ada, b_ada, w_in, fn_w, fn_b, dn_conv, dn_a_log,
              dn_dt_bias, dn_norm, hg_lb_logits, hg_norm, da_lambda, da_norm, w_branch, w_out,
              final_g):
    bsz, t, _ = x.shape
    ang_r, ang_c = _axial_angles(t)
    lb_all = jnp.cumsum(jax.nn.softmax(hg_lb_logits.astype(jnp.float32), axis=1), axis=1)
    lb_all = lb_all - lb_all[:, :1]
    silu_c = jax.nn.silu(c)
    silu_cc = jax.nn.silu(c_ctx)
    xl, xc = x, ctx
    for l in range(DEPTH):
        last = l == DEPTH - 1
        mod_l = (silu_c @ w_ada[l] + b_ada[l])[:, None, :]
        mod_c = silu_cc @ w_ada[l] + b_ada[l]
        pl, gate_l = _stream_in(xl, mod_l, norm_g[l], w_in[l])
        pc, gate_c = _stream_in(xc, mod_c, norm_g[l], w_in[l])

        zs = jnp.zeros((bsz, DN_HEADS, DN_DK, DN_DV), jnp.float32)
        o_dn_c, s_f, s_b = _dn_bidir(*_dn_prep(pc, dn_conv[l], dn_a_log[l], dn_dt_bias[l]), zs, zs)
        o_dn_l, _, _ = _dn_bidir(*_dn_prep(pl, dn_conv[l], dn_a_log[l], dn_dt_bias[l]), s_f, s_b)

        zh = jnp.zeros((bsz, HG_HEADS, HG_DK, HG_DV), jnp.float32)
        o_hg_c, h_f, h_b = _hg_bidir(*_hg_prep(pc, lb_all[:, l]), zh, zh)
        o_hg_l, _, _ = _hg_bidir(*_hg_prep(pl, lb_all[:, l]), h_f, h_b)

        lam_init = 0.8 - 0.6 * math.exp(-0.3 * l)
        lp = da_lambda[l].astype(jnp.float32)
        lam = jnp.exp(jnp.sum(lp[0] * lp[1])) - jnp.exp(jnp.sum(lp[2] * lp[3])) + lam_init
        qc, kc, vc = _da_prep(pc)
        ql, kl, vl = _da_prep(pl)
        ql = _axial_rope(ql, ang_r, ang_c)
        kl = _axial_rope(kl, ang_r, ang_c)
        o_da_l = _diff_latent(ql, jnp.concatenate([kl, kc], axis=1),
                              jnp.concatenate([vl, vc], axis=1), lam)

        ys_l = _branches(pl, o_dn_l, o_hg_l, o_da_l, fn_w[l], fn_b[l], dn_norm[l], hg_norm[l],
                         da_norm[l], lam_init)
        new_xl = xl + gate_l * _merge(pl['gate'], ys_l, w_branch[l], w_out[l])
        if not last:
            o_da_c = _diff_block(qc, kc, vc, lam)
            ys_c = _branches(pc, o_dn_c, o_hg_c, o_da_c, fn_w[l], fn_b[l], dn_norm[l], hg_norm[l],
                             da_norm[l], lam_init)
            xc = xc + gate_c * _merge(pc['gate'], ys_c, w_branch[l], w_out[l])
        xl = new_xl
    return _rms(xl, final_g)
```

```cpp
#include <hip/hip_runtime.h>
#include <hip/hip_cooperative_groups.h>
#include <cstdio>
namespace cg = cooperative_groups;

#define DI __device__ __forceinline__
typedef unsigned short bfr;
using bf16x8 = __attribute__((ext_vector_type(8))) short;
using s16x4  = __attribute__((ext_vector_type(4))) short;
using f32x16 = __attribute__((ext_vector_type(16))) float;
using f32x4  = __attribute__((ext_vector_type(4))) float;
using u32x4  = __attribute__((ext_vector_type(4))) unsigned;
using u32x2  = __attribute__((ext_vector_type(2))) unsigned;
typedef __bf16 bf2_t __attribute__((ext_vector_type(2)));
typedef float f2_t __attribute__((ext_vector_type(2)));
#define MFMA(a, b, c) __builtin_amdgcn_mfma_f32_32x32x16_bf16((a), (b), (c), 0, 0, 0)

constexpr int NB = 4, SEQ = 4096, CTX = 256, SP = 4352, NTOK = 17408, DM = 2048;
constexpr int PLD = 16384, NWIN = 16384, INW = 15888;
constexpr int C_FNZ = 1024, C_DNQ = 1536, C_DNK = 2048, C_DNV = 2560, C_DNZ = 3072, C_HGQ = 3584, C_HGF = 4096,
              C_HGI = 5120, C_HGZ = 5632, C_DAQ = 6144, C_DAK = 6656, C_DAV = 7168, C_DAZ = 7680, C_GATE = 8192;
constexpr float EPS = 1e-6f;
constexpr int DN_UNITS = 2 * 4 * 4 * 68, DN_USZ = 36864;
constexpr int HG_UNITS = 2 * 4 * 4 * 136, HG_USZ = 12288;

constexpr size_t al(size_t x) { return (x + 255) & ~(size_t)255; }
constexpr size_t O_X = 0;
constexpr size_t O_H = O_X + al((size_t)NTOK * DM * 4);
constexpr size_t O_P = O_H + al((size_t)NTOK * DM * 2);
constexpr size_t O_AB = O_P + al((size_t)NTOK * PLD * 2);
constexpr size_t O_FTL = O_AB + al((size_t)NTOK * 16 * 4);
constexpr size_t O_FTC = O_FTL + al((size_t)4 * 512 * 8192 * 2);
constexpr size_t O_VT = O_FTC + al((size_t)4 * 512 * 512 * 2);
constexpr size_t O_F = O_VT + al((size_t)NTOK * 512 * 2);
constexpr size_t O_YS = O_F + al((size_t)NTOK * 512 * 2);
constexpr size_t O_Y = O_YS + al((size_t)NTOK * DM * 2);
constexpr size_t O_WIN = O_Y + al((size_t)NTOK * DM * 2);
constexpr size_t O_WBR = O_WIN + al((size_t)4 * NWIN * DM * 2);
constexpr size_t O_WOUT = O_WBR + al((size_t)16 * 2048 * 512 * 2);
constexpr size_t O_FNW = O_WOUT + al((size_t)4 * 2048 * 2048 * 2);
constexpr size_t O_DFTL = O_FNW + al((size_t)4 * 512 * 512 * 2);
constexpr size_t O_DFTC = O_DFTL + al((size_t)4096 * 8192 * 2);
constexpr size_t O_ROPE = O_DFTC + al((size_t)256 * 512 * 2);
constexpr size_t O_MODS = O_ROPE + al((size_t)4096 * 32 * 2 * 4);
constexpr size_t O_LB = O_MODS + al((size_t)4 * 5 * 6144 * 4);
constexpr size_t O_LAM = O_LB + al((size_t)4 * 2 * 512 * 4);
constexpr size_t O_CTR = O_LAM + 256;
constexpr size_t O_BAR = O_CTR + 256;
constexpr size_t O_DNU = O_BAR + 64 * 17 * 4 + 256;
constexpr size_t O_DNG = O_DNU + al((size_t)DN_UNITS * DN_USZ * 2);
constexpr size_t O_ODN = O_DNG + al((size_t)DN_UNITS * 4);
constexpr size_t O_HGU = O_ODN + al((size_t)2 * NTOK * 512 * 4);
constexpr size_t O_HGD = O_HGU + al((size_t)HG_UNITS * HG_USZ * 2);
constexpr size_t O_OHG = O_HGD + al((size_t)HG_UNITS * 128 * 4);
constexpr size_t O_END = O_OHG + al((size_t)2 * NTOK * 512 * 4);

struct Params {
  const float *x, *c, *ctx, *c_ctx, *norm_g, *w_ada, *b_ada, *w_in, *fn_w, *fn_b, *dn_conv, *dn_a_log, *dn_dt_bias,
      *dn_norm, *hg_lb_logits, *hg_norm, *da_lambda, *da_norm, *w_branch, *w_out, *final_g;
  float* out;
  unsigned char* ws;
};

constexpr int SMEM_BYTES = 73728;

DI float bf2f(bfr v) { return __uint_as_float(((unsigned)v) << 16); }
DI unsigned pk2(float a, float b) { f2_t v = {a, b}; bf2_t r = __builtin_convertvector(v, bf2_t); return __builtin_bit_cast(unsigned, r); }
DI bfr f2bf(float a) { return (bfr)(pk2(a, 0.f) & 0xffffu); }
DI float sigmoidf_(float x) { return 1.f / (1.f + __expf(-x)); }
DI float siluf_(float x) { return x / (1.f + __expf(-x)); }
DI int crow(int r, int h) { return (r & 3) + 8 * (r >> 2) + 4 * h; }
template <int S> DI bf16x8 pack8(const f32x16& x) {
  u32x4 p;
  p[0] = pk2(x[8 * S + 0], x[8 * S + 1]); p[1] = pk2(x[8 * S + 2], x[8 * S + 3]);
  p[2] = pk2(x[8 * S + 4], x[8 * S + 5]); p[3] = pk2(x[8 * S + 6], x[8 * S + 7]);
  return __builtin_bit_cast(bf16x8, p);
}
DI bf16x8 ld16(const bfr* p) { return *(const bf16x8*)p; }
DI bf16x8 ld2x8(const bfr* p) {
  s16x4 lo = *(const s16x4*)p, hi = *(const s16x4*)(p + 8);
  return __builtin_shufflevector(lo, hi, 0, 1, 2, 3, 4, 5, 6, 7);
}
DI unsigned char* launder_ptr(unsigned char* q) { asm volatile("" : "+s"(q)); return q; }
DI int opaque_tid() { int t = threadIdx.x; asm volatile("" : "+v"(t)); return t; }
DI int fragp_idx(int row, int col, int KB) {
  const int rb = row >> 5, l31 = row & 31, kb = col >> 5, c = col & 31;
  const int s = c >> 4, jhi = (c >> 3) & 1, h = (c >> 2) & 1, jlo = c & 3;
  return ((((rb * KB + kb) * 2 + s) * 64 + h * 32 + l31) << 3) + jhi * 4 + jlo;
}
DI int fragn_idx(int row, int col, int KS) {
  const int rb = row >> 5, l31 = row & 31, s = col >> 4, h = (col >> 3) & 1, j = col & 7;
  return (((rb * KS + s) * 64 + h * 32 + l31) << 3) + j;
}
DI f32x16 zero16() { f32x16 z; for (int i = 0; i < 16; ++i) z[i] = 0.f; return z; }
DI int mod_vec(int row) { int b = row / SP, s = row - b * SP; return s < CTX ? 4 : b; }

template <int ROWS>
DI void stage_tile(const bfr* __restrict__ G, int ld, unsigned char* lds, int tid) {
#pragma unroll
  for (int i = 0; i < ROWS / 32; ++i) {
    const int ci = i * 256 + tid, line = ci >> 4, slot = ci & 15, v = slot ^ (line & 15), r = line * 2 + (v >> 3), c16 = v & 7;
    __builtin_amdgcn_global_load_lds((const __attribute__((address_space(1))) void*)(G + (size_t)r * ld + c16 * 8),
                                     (__attribute__((address_space(3))) void*)(lds + ci * 16), 16, 0, 0);
  }
}
template <int NI>
DI void gemm_main(const bfr* __restrict__ A, int lda, const bfr* __restrict__ Bt, int ldb, int K, f32x16 (&acc)[2][NI], bfr* sA_, bfr* sB_) {
  const int tid = opaque_tid(), lane = tid & 63, wv = tid >> 6, wm = wv >> 1, wn = wv & 1, l31 = lane & 31, h = lane >> 5;
  unsigned char* const base = (unsigned char*)sA_;
  constexpr int BUFSZ = 16384 + 8192 * NI;
  const int lane_off = (l31 >> 1) * 256, y = (((l31 & 1) << 3) ^ (l31 >> 1) ^ h);
  const int nk = K >> 6;
  __syncthreads();
  stage_tile<128>(A, lda, base, tid);
  stage_tile<64 * NI>(Bt, ldb, base + 16384, tid);
  for (int kt = 0; kt < nk; ++kt) {
    asm volatile("s_waitcnt vmcnt(0)" ::: "memory");
    __builtin_amdgcn_s_barrier();
    const unsigned char* cur = base + (kt & 1) * BUFSZ;
    bf16x8 af[4][2], bq[4][NI];
#pragma unroll
    for (int ks = 0; ks < 4; ++ks) {
      const int so = ((y ^ (2 * ks)) << 4) + lane_off;
#pragma unroll
      for (int i = 0; i < 2; ++i) af[ks][i] = *(const bf16x8*)(cur + (wm * 32 + i * 16) * 256 + so);
#pragma unroll
      for (int i = 0; i < NI; ++i) bq[ks][i] = *(const bf16x8*)(cur + 16384 + (wn * 16 * NI + i * 16) * 256 + so);
    }
    __builtin_amdgcn_sched_barrier(0);
    if (kt + 1 < nk) {
      unsigned char* nxt = base + ((kt + 1) & 1) * BUFSZ;
      stage_tile<128>(A + (kt + 1) * 64, lda, nxt, tid);
      stage_tile<64 * NI>(Bt + (kt + 1) * 64, ldb, nxt + 16384, tid);
    }
    __builtin_amdgcn_sched_barrier(0);
#pragma unroll
    for (int ks = 0; ks < 4; ++ks)
#pragma unroll
      for (int mi = 0; mi < 2; ++mi)
#pragma unroll
        for (int ni = 0; ni < NI; ++ni) acc[mi][ni] = MFMA(af[ks][mi], bq[ks][ni], acc[mi][ni]);
  }
}

template <int ROWS>
DI void stage_tile32(const bfr* __restrict__ G, unsigned char* lds, int tid) {
#pragma unroll
  for (int i = 0; i < ROWS / 64; ++i) {
    const int ci = i * 256 + tid, line = ci >> 4, slot = ci & 15, r = line * 4 + (slot >> 2), c16 = (slot & 3) ^ (line & 3);
    __builtin_amdgcn_global_load_lds((const __attribute__((address_space(1))) void*)(G + r * 32 + c16 * 8),
                                     (__attribute__((address_space(3))) void*)(lds + ci * 16), 16, 0, 0);
  }
}
DI bf16x8 lds_read16_asm(unsigned addr) {
  bf16x8 r;
  asm volatile("ds_read_b128 %0, %1" : "=v"(r) : "v"(addr));
  return r;
}
DI void gemm_big(const bfr* __restrict__ A, size_t sa, const bfr* __restrict__ Bt, size_t sb, int K, f32x16 (&acc)[2][4], unsigned char* base) {
  const int tid = opaque_tid(), lane = tid & 63, wv = tid >> 6, wm = wv >> 1, wn = wv & 1, l31 = lane & 31, h = lane >> 5;
  constexpr int BUFSZ = 8192 + 16384;
  const int lane_off = (l31 >> 2) * 256 + (l31 & 3) * 64, x = (l31 >> 2) & 3;
  const int nk = K >> 5;
  const unsigned lbase = (unsigned)(size_t)base;
  __syncthreads();
  stage_tile32<128>(A, base, tid);
  stage_tile32<256>(Bt, base + 8192, tid);
  stage_tile32<128>(A + sa, base + BUFSZ, tid);
  stage_tile32<256>(Bt + sb, base + BUFSZ + 8192, tid);
  int bc = 0;
  for (int kt = 0; kt < nk; ++kt) {
    if (kt + 1 < nk) asm volatile("s_waitcnt vmcnt(6)" ::: "memory");
    else asm volatile("s_waitcnt vmcnt(0)" ::: "memory");
    __builtin_amdgcn_s_barrier();
    const unsigned cur = lbase + bc * BUFSZ;
    bf16x8 af[2][2], bq[2][4];
#pragma unroll
    for (int ks = 0; ks < 2; ++ks) {
      const unsigned so = cur + lane_off + ((((ks * 2) | h) ^ x) << 4);
#pragma unroll
      for (int i = 0; i < 2; ++i) af[ks][i] = lds_read16_asm(so + (wm * 16 + i * 8) * 256);
#pragma unroll
      for (int i = 0; i < 4; ++i) bq[ks][i] = lds_read16_asm(so + 8192 + (wn * 32 + i * 8) * 256);
    }
    if (kt + 2 < nk) {
      const int bn = bc >= 1 ? bc - 1 : 2;
      unsigned char* nxt = base + bn * BUFSZ;
      stage_tile32<128>(A + (size_t)(kt + 2) * sa, nxt, tid);
      stage_tile32<256>(Bt + (size_t)(kt + 2) * sb, nxt + 8192, tid);
    }
    asm volatile("s_waitcnt lgkmcnt(0)"
                 : "+v"(af[0][0]), "+v"(af[0][1]), "+v"(af[1][0]), "+v"(af[1][1]), "+v"(bq[0][0]), "+v"(bq[0][1]), "+v"(bq[0][2]), "+v"(bq[0][3]),
                   "+v"(bq[1][0]), "+v"(bq[1][1]), "+v"(bq[1][2]), "+v"(bq[1][3])
                 :: "memory");
#pragma unroll
    for (int ks = 0; ks < 2; ++ks)
#pragma unroll
      for (int mi = 0; mi < 2; ++mi)
#pragma unroll
        for (int ni = 0; ni < 4; ++ni) acc[mi][ni] = MFMA(af[ks][mi], bq[ks][ni], acc[mi][ni]);
    bc = bc == 2 ? 0 : bc + 1;
  }
}

DI bool tile_order(int it, int nM, int nN, int SM, int SN, int& mt, int& nt) {
  const int G = gridDim.x, xcd = blockIdx.x & 7, local = blockIdx.x >> 3, per = G >> 3;
  const int sN = nN / SN, nsup = (nM / SM) * sN, ST = SM * SN;
  const long j = (long)it * per + local;
  const int sup = xcd + 8 * (int)(j / ST), within = (int)(j % ST);
  if (sup >= nsup) { mt = -1; return false; }
  const int sm = sup / sN, sn = sup % sN;
  mt = sm * SM + within / SN; nt = sn * SN + within % SN;
  return true;
}

DI bool tile_order_mfast(int it, int nM, int nN, int SM, int SN, int& mt, int& nt) {
  const int G = gridDim.x, xcd = blockIdx.x & 7, local = blockIdx.x >> 3, per = G >> 3;
  const int sM = nM / SM, nsup = sM * (nN / SN), ST = SM * SN;
  const long j = (long)it * per + local;
  const int sup = xcd + 8 * (int)(j / ST), within = (int)(j % ST);
  if (sup >= nsup) { mt = -1; return false; }
  const int sm = sup % sM, sn = sup / sM;
  mt = sm * SM + within / SN; nt = sn * SN + within % SN;
  return true;
}

DI int win_srccol(int n) { return n < 3584 ? n - 512 : n - 496; }

DI void tr_tile(const float* __restrict__ src, int ldsrc, int k0, int n0, bool winmap, bfr* __restrict__ dst, int lddst, float* sT, int slab_rows = 0) {
  const int tid = opaque_tid();
  __syncthreads();
  {
    const int nn = tid & 63;
    const int sc = winmap ? win_srccol(n0 + nn) : (n0 + nn);
    float tv[64];
#pragma unroll
    for (int i = 0; i < 64; ++i) {
      const int kk = (tid >> 6) + 4 * i;
      tv[i] = sc >= 0 ? src[(size_t)(k0 + kk) * ldsrc + sc] : 0.f;
    }
#pragma unroll
    for (int i = 0; i < 64; ++i) sT[((tid >> 6) + 4 * i) * 65 + nn] = tv[i];
  }
  __syncthreads();
#pragma unroll
  for (int i = 0; i < 8; ++i) {
    const int e = tid + 256 * i, w = e >> 6, lane = e & 63;
    const int nn = (w >> 2) * 8 + (lane >> 3), kc = (w & 3) * 8 + (lane & 7);
    const float* s = sT + (8 * kc) * 65 + nn;
    u32x4 o;
    o[0] = pk2(s[0], s[65]); o[1] = pk2(s[130], s[195]); o[2] = pk2(s[260], s[325]); o[3] = pk2(s[390], s[455]);
    const int k = k0 + 8 * kc;
    if (slab_rows) *(u32x4*)(dst + ((size_t)(k >> 5) * slab_rows + (n0 + nn)) * 32 + (k & 31)) = o;
    else *(u32x4*)(dst + (size_t)(n0 + nn) * lddst + k) = o;
  }
}

DI void phase0(const Params& p, unsigned char* smem) {
  unsigned char* const WS_ = launder_ptr(p.ws);
  const int tid = opaque_tid(), lane = tid & 63, wv = tid >> 6;
  float* sF = (float*)smem;
  bfr* WIN = (bfr*)(WS_ + O_WIN); bfr* WBR = (bfr*)(WS_ + O_WBR); bfr* WOUT = (bfr*)(WS_ + O_WOUT); bfr* FNW = (bfr*)(WS_ + O_FNW);
  constexpr int I_MODS = 384, I_WIN = 4 * 240 * 8, I_WBR = 16 * 32 * 2, I_WOUT = 4 * 32 * 8, I_FNW = 4 * 8 * 2, I_FOLD = 512,
                I_DFTL = 4096, I_DFTC = 256, I_ROPE = 512, I_X = NTOK / 8, I_MISC = 1;
  constexpr int B1 = I_MODS, B2 = B1 + I_WIN, B3 = B2 + I_WBR, B4 = B3 + I_WOUT, B5 = B4 + I_FNW, B6 = B5 + I_FOLD, B7 = B6 + I_DFTL,
                B8 = B7 + I_DFTC, B9 = B8 + I_ROPE, B10 = B9 + I_X, B11 = B10 + I_MISC;
  for (int it = blockIdx.x; it < B11; it += gridDim.x) {
    if (it < B1) {
      __syncthreads();
      for (int e = tid; e < 5 * 2048; e += 256) { const float cv = e < 4 * 2048 ? p.c[e] : p.c_ctx[e - 4 * 2048]; sF[e] = siluf_(cv); }
      __syncthreads();
      const int l = it / 96, j = (it % 96) * 64 + lane, kq = wv;
      const float* w = p.w_ada + (size_t)l * 2048 * 6144 + j;
      float a0 = 0.f, a1 = 0.f, a2 = 0.f, a3 = 0.f, a4 = 0.f;
#pragma unroll 32
      for (int k = kq * 512; k < kq * 512 + 512; ++k) {
        const float wv_ = w[(size_t)k * 6144];
        a0 += sF[k] * wv_; a1 += sF[2048 + k] * wv_; a2 += sF[4096 + k] * wv_; a3 += sF[6144 + k] * wv_; a4 += sF[8192 + k] * wv_;
      }
      float* red = sF + 10240 + (kq * 5) * 64 + lane;
      red[0] = a0; red[64] = a1; red[128] = a2; red[192] = a3; red[256] = a4;
      __syncthreads();
      if (wv == 0) {
        const float bb = p.b_ada[l * 6144 + j];
        float* M = (float*)(WS_ + O_MODS) + (size_t)l * 5 * 6144 + j;
        for (int v = 0; v < 5; ++v) {
          const float* r = sF + 10240 + v * 64 + lane;
          M[(size_t)v * 6144] = r[0] + r[320] + r[640] + r[960] + bb;
        }
      }
    } else if (it < B2) {
      const int r = it - B1, l = r / (240 * 8), q = r % (240 * 8), ntile = q / 8, kt = q % 8;
      tr_tile(p.w_in + (size_t)l * 2048 * INW, INW, kt * 256, 1024 + ntile * 64, true, WIN + (size_t)l * NWIN * DM, DM, sF, NWIN);
    } else if (it < B3) {
      const int r = it - B2, mtx = r / 64, q = r % 64, ntile = q / 2, kt = q % 2;
      tr_tile(p.w_branch + (size_t)mtx * 512 * 2048, 2048, kt * 256, ntile * 64, false, WBR + (size_t)mtx * 2048 * 512, 512, sF);
    } else if (it < B4) {
      const int r = it - B3, l = r / 256, q = r % 256, ntile = q / 8, kt = q % 8;
      tr_tile(p.w_out + (size_t)l * 2048 * 2048, 2048, kt * 256, ntile * 64, false, WOUT + (size_t)l * 2048 * 2048, 2048, sF);
    } else if (it < B5) {
      const int r = it - B4, l = r / 16, q = r % 16, ntile = q / 2, kt = q % 2;
      tr_tile(p.fn_w + (size_t)l * 512 * 512, 512, kt * 256, ntile * 64, false, FNW + (size_t)l * 512 * 512, 512, sF);
    } else if (it < B6) {
      const int r = it - B5, l = r / 128, g = (r / 32) & 3, kt = r & 31, k0 = kt * 64;
      float* sW = sF;
      float* tc = sF + 64 * 129;
      __syncthreads();
      for (int e = tid; e < 64 * 128; e += 256) { const int kk = e >> 7, cc = e & 127; sW[kk * 129 + cc] = p.w_in[((size_t)l * 2048 + k0 + kk) * INW + g * 128 + cc]; }
      if (tid < 128) { tc[tid] = cospif((float)tid / 64.f) * 0.08838834764831845f; tc[128 + tid] = sinpif((float)tid / 64.f) * 0.08838834764831845f; }
      __syncthreads();
      {
        const int l31f = lane & 31, hf = lane >> 5;
#pragma unroll 1
        for (int cb2 = 0; cb2 < 2; ++cb2) {
          const int cb = wv * 2 + cb2;
          const int colg = cb * 32 + l31f, part = colg >> 7, cp = colg & 127;
          const float* tb = tc + part * 128;
          f32x16 o0 = zero16(), o1 = zero16();
#pragma unroll 8
          for (int s = 0; s < 64; ++s) {
            const int cc = 2 * s + hf;
            const float bv = tb[(cc * cp) & 127];
            o0 = __builtin_amdgcn_mfma_f32_32x32x2f32(sW[l31f * 129 + cc], bv, o0, 0, 0, 0);
            o1 = __builtin_amdgcn_mfma_f32_32x32x2f32(sW[(32 + l31f) * 129 + cc], bv, o1, 0, 0, 0);
          }
          bfr* dstn = WIN + (size_t)l * NWIN * DM + (size_t)(part * 512 + g * 128 + cp) * 32;
#pragma unroll
          for (int rb2 = 0; rb2 < 2; ++rb2) {
            const f32x16& oo = rb2 ? o1 : o0;
#pragma unroll
            for (int gq = 0; gq < 4; ++gq) {
              const int kr = k0 + rb2 * 32 + 8 * gq + 4 * hf;
              u32x2 w; w[0] = pk2(oo[4 * gq], oo[4 * gq + 1]); w[1] = pk2(oo[4 * gq + 2], oo[4 * gq + 3]);
              *(u32x2*)(dstn + (size_t)(kr >> 5) * NWIN * 32 + (kr & 31)) = w;
            }
          }
        }
      }
    } else if (it < B7) {
      const int f = it - B6;
      unsigned* dst = (unsigned*)(WS_ + O_DFTL) + (size_t)f * 4096;
      for (int e = tid; e < 4096; e += 256) {
        float v[2];
        for (int q = 0; q < 2; ++q) {
          const int kk = 2 * e + q, k = kk & 4095, m = (f * k) & 4095;
          v[q] = (kk >> 12) ? -sinpif((float)m / 2048.f) * 0.015625f : cospif((float)m / 2048.f) * 0.015625f;
        }
        dst[e] = pk2(v[0], v[1]);
      }
    } else if (it < B8) {
      const int f = it - B7;
      unsigned* dst = (unsigned*)(WS_ + O_DFTC) + (size_t)f * 256;
      {
        const int e = tid;
        float v[2];
        for (int q = 0; q < 2; ++q) {
          const int kk = 2 * e + q, k = kk & 255, m = (f * k) & 255;
          v[q] = (kk >> 8) ? -sinpif((float)m / 128.f) * 0.0625f : cospif((float)m / 128.f) * 0.0625f;
        }
        dst[e] = pk2(v[0], v[1]);
      }
    } else if (it < B9) {
      const int e = (it - B8) * 256 + tid, pos = e >> 5, a = e & 31;
      const float inv = powf(10000.f, -(float)(a & 15) / 16.f);
      const float ang = (a < 16 ? (float)(pos >> 6) : (float)(pos & 63)) * inv;
      float* R = (float*)(WS_ + O_ROPE) + (size_t)e * 2;
      R[0] = cosf(ang); R[1] = sinf(ang);
    } else if (it < B10) {
      const int r0 = (it - B9) * 8;
      f32x4* X = (f32x4*)(WS_ + O_X);
      for (int e = tid; e < 8 * 512; e += 256) {
        const int row = r0 + (e >> 9), cc = e & 511, b = row / SP, s = row - b * SP;
        const f32x4* src = s < CTX ? (const f32x4*)(p.ctx + ((size_t)b * CTX + s) * DM) : (const f32x4*)(p.x + ((size_t)b * SEQ + s - CTX) * DM);
        X[(size_t)row * 512 + cc] = src[cc];
      }
    } else {
      for (int e = tid; e < 1024; e += 256) {
        const int d = e >> 9, cc = e & 511;
        float lg[4], mx = -1e30f;
        for (int l = 0; l < 4; ++l) { lg[l] = p.hg_lb_logits[(d * 4 + l) * 512 + cc]; mx = fmaxf(mx, lg[l]); }
        float sum = 0.f;
        for (int l = 0; l < 4; ++l) { lg[l] = expf(lg[l] - mx); sum += lg[l]; }
        float cum = 0.f;
        float* LBp = (float*)(WS_ + O_LB);
        for (int l = 0; l < 4; ++l) { if (l > 0) cum += lg[l] / sum; LBp[(l * 2 + d) * 512 + cc] = cum; }
      }
      if (tid < 4) {
        const float* lp = p.da_lambda + tid * 256;
        float s1 = 0.f, s2 = 0.f;
        for (int d = 0; d < 64; ++d) { s1 += lp[d] * lp[64 + d]; s2 += lp[128 + d] * lp[192 + d]; }
        const float lam_init = 0.8f - 0.6f * expf(-0.3f * (float)tid);
        ((float*)(WS_ + O_LAM))[tid] = expf(s1) - expf(s2) + lam_init;
      }
      if (tid < 16) ((unsigned*)(WS_ + O_CTR))[tid] = 0u;
      for (int e = tid; e < 64 * 17; e += 256) ((unsigned*)(WS_ + O_BAR))[e] = 0u;
    }
  }
}

DI void phase_adaln(const Params& p, int l, unsigned char* smem) {
  unsigned char* const WS_ = launder_ptr(p.ws);
  const int tid_ = opaque_tid(), lane = tid_ & 63, gw = blockIdx.x * 4 + (tid_ >> 6), nw = gridDim.x * 4;
  const float* X = (const float*)(WS_ + O_X);
  bfr* H = (bfr*)(WS_ + O_H);
  float* AB = (float*)(WS_ + O_AB);
  const float* ng = p.norm_g + l * DM;
  bfr* sW = (bfr*)smem;
  __syncthreads();
  {
    const float* wsrc = p.w_in + (size_t)l * 2048 * INW + 3072;
    f32x4 t[32];
#pragma unroll
    for (int i = 0; i < 32; ++i) { const int e = tid_ + 256 * i, k = e >> 2, c4 = e & 3; t[i] = *(const f32x4*)(wsrc + (size_t)k * INW + 4 * c4); }
#pragma unroll
    for (int i = 0; i < 32; ++i) {
      const int e = tid_ + 256 * i, k = e >> 2, c4 = e & 3;
      u32x2 w; w[0] = pk2(t[i][0], t[i][1]); w[1] = pk2(t[i][2], t[i][3]);
      const int pos = ((k >> 8) * 4 + (k & 3)) * 64 + ((k >> 2) & 63);
      *(u32x2*)(sW + (c4 >> 1) * 16384 + pos * 8 + (c4 & 1) * 4) = w;
    }
  }
  __syncthreads();
  for (int row = gw; row < NTOK; row += nw) {
    const float* M = (const float*)(WS_ + O_MODS) + ((size_t)l * 5 + mod_vec(row)) * 6144;
    const f32x4* xr = (const f32x4*)(X + (size_t)row * DM);
    f32x4 v[8]; float ss = 0.f;
#pragma unroll
    for (int j = 0; j < 8; ++j) { v[j] = xr[lane + 64 * j]; ss += v[j][0] * v[j][0] + v[j][1] * v[j][1] + v[j][2] * v[j][2] + v[j][3] * v[j][3]; }
#pragma unroll
    for (int o = 1; o < 64; o <<= 1) ss += __shfl_xor(ss, o);
    const float rs = rsqrtf(ss * (1.f / DM) + EPS);
    float ab[16];
#pragma unroll
    for (int c = 0; c < 16; ++c) ab[c] = 0.f;
#pragma unroll
    for (int j = 0; j < 8; ++j) {
      const int c0 = 4 * (lane + 64 * j);
      const f32x4 g = *(const f32x4*)(ng + c0), sh = *(const f32x4*)(M + c0), sc = *(const f32x4*)(M + 2048 + c0);
      float o[4];
      for (int q = 0; q < 4; ++q) o[q] = v[j][q] * rs * g[q] * (1.f + sc[q]) + sh[q];
      u32x2 w; w[0] = pk2(o[0], o[1]); w[1] = pk2(o[2], o[3]);
      *(u32x2*)(H + ((size_t)(c0 >> 5) * NTOK + row) * 32 + (c0 & 31)) = w;
#pragma unroll
      for (int q = 0; q < 4; ++q) {
        const bf16x8 w0 = ld16(sW + ((j * 4 + q) * 64 + lane) * 8), w1 = ld16(sW + 16384 + ((j * 4 + q) * 64 + lane) * 8);
#pragma unroll
        for (int c = 0; c < 8; ++c) { ab[c] += o[q] * bf2f((bfr)w0[c]); ab[8 + c] += o[q] * bf2f((bfr)w1[c]); }
      }
    }
#pragma unroll
    for (int c = 0; c < 16; ++c) {
      float s = ab[c];
#pragma unroll
      for (int o = 1; o < 64; o <<= 1) s += __shfl_xor(s, o);
      ab[c] = s;
    }
    float mine = 0.f;
#pragma unroll
    for (int c = 0; c < 16; ++c) mine = (lane == c) ? ab[c] : mine;
    if (lane < 16) AB[(size_t)row * 16 + lane] = mine;
  }
}

DI void phase_inproj(const Params& p, int l, unsigned char* smem) {
  unsigned char* const WS_ = launder_ptr(p.ws);
  const int tid = opaque_tid(), lane = tid & 63, wv = tid >> 6, wm = wv >> 1, wn = wv & 1, l31 = lane & 31, h = lane >> 5;
  bfr* sA = (bfr*)smem; bfr* sB = sA + 128 * 72;
  const bfr* H = (const bfr*)(WS_ + O_H);
  const bfr* W = (const bfr*)(WS_ + O_WIN) + (size_t)l * NWIN * DM;
  bfr* P = (bfr*)(WS_ + O_P);
  float* AB = (float*)(WS_ + O_AB);
  bfr* FTL = (bfr*)(WS_ + O_FTL); bfr* FTC = (bfr*)(WS_ + O_FTC); bfr* VT = (bfr*)(WS_ + O_VT);
  const float* ROPE = (const float*)(WS_ + O_ROPE);
  for (int it = 0;; ++it) {
    int mt, nt;
    if (!tile_order_mfast(it, 136, 64, 34, 2, mt, nt)) break;
    if (mt < 0) continue;
    const int m0 = mt * 128, n0 = nt * 256;
    f32x16 acc[2][4];
    for (int i = 0; i < 2; ++i) for (int j = 0; j < 4; ++j) acc[i][j] = zero16();
    gemm_big(H + (size_t)m0 * 32, (size_t)NTOK * 32, W + (size_t)n0 * 32, (size_t)NWIN * 32, DM, acc, smem);
    const int b = m0 / SP, s0 = m0 - b * SP;
    const bool isctx = s0 < CTX;
#pragma unroll
    for (int mi = 0; mi < 2; ++mi)
#pragma unroll
      for (int ni = 0; ni < 4; ++ni) {
        const int cb = n0 + wn * 128 + ni * 32, col = cb + l31, rb = wm * 64 + mi * 32;
        const f32x16& a = acc[mi][ni];
        if (n0 < 1024) {
          const int part = n0 >> 9, ch = col & 511;
#pragma unroll
          for (int g = 0; g < 4; ++g) {
            const int rr = rb + 8 * g + 4 * h;
            u32x2 w; w[0] = pk2(a[4 * g], a[4 * g + 1]); w[1] = pk2(a[4 * g + 2], a[4 * g + 3]);
            if (isctx) *(u32x2*)(FTC + ((size_t)(b * 512 + ch)) * 512 + part * 256 + s0 + rr) = w;
            else *(u32x2*)(FTL + ((size_t)(b * 512 + ch)) * 8192 + part * 4096 + (s0 - CTX) + rr) = w;
          }
        } else if (n0 >= C_DAV && n0 < C_DAZ) {
          const int cc = col - C_DAV;
#pragma unroll
          for (int g = 0; g < 4; ++g) {
            const int rr = rb + 8 * g + 4 * h;
            u32x2 w; w[0] = pk2(a[4 * g], a[4 * g + 1]); w[1] = pk2(a[4 * g + 2], a[4 * g + 3]);
            *(u32x2*)(VT + ((size_t)(b * 512 + cc)) * SP + s0 + rr) = w;
          }
        } else if (n0 >= C_DAQ && n0 < C_DAV && !isctx) {
          const int aidx = ((cb >> 5) & 1) * 16 + (l31 & 15);
          const bool lo = (l31 & 16) == 0;
#pragma unroll
          for (int r = 0; r < 16; ++r) {
            const int rr = rb + crow(r, h), pos = s0 - CTX + rr;
            const float v = a[r], o = __shfl_xor(v, 16);
            const float cs = ROPE[((size_t)pos * 32 + aidx) * 2], sn = ROPE[((size_t)pos * 32 + aidx) * 2 + 1];
            const float res = lo ? v * cs - o * sn : v * cs + o * sn;
            P[(size_t)(m0 + rr) * PLD + col] = f2bf(res);
          }
        } else {
#pragma unroll
          for (int r = 0; r < 16; ++r) P[(size_t)(m0 + rb + crow(r, h)) * PLD + col] = f2bf(a[r]);
        }
      }
  }
}

DI void dft_tile(const Params& p, int t, unsigned char* smem) {
  unsigned char* const WS_ = launder_ptr(p.ws);
  const int tid = opaque_tid(), lane = tid & 63, wv = tid >> 6, wm = wv >> 1, wn = wv & 1, l31 = lane & 31, h = lane >> 5;
  bfr* sA = (bfr*)smem; bfr* sB = sA + 128 * 72;
  bfr* F = (bfr*)(WS_ + O_F);
  const bfr *A, *Bt; int lda, K, rowbase, nt;
  if (t < 512) {
    const int b = t >> 7, q = t & 127, mt = q >> 2; nt = q & 3;
    A = (const bfr*)(WS_ + O_DFTL) + (size_t)mt * 128 * 8192; lda = 8192; K = 8192;
    Bt = (const bfr*)(WS_ + O_FTL) + ((size_t)b * 512 + nt * 128) * 8192;
    rowbase = b * SP + CTX + mt * 128;
  } else {
    const int q = t - 512, b = q >> 3, mt = (q >> 2) & 1; nt = q & 3;
    A = (const bfr*)(WS_ + O_DFTC) + (size_t)mt * 128 * 512; lda = 512; K = 512;
    Bt = (const bfr*)(WS_ + O_FTC) + ((size_t)b * 512 + nt * 128) * 512;
    rowbase = b * SP + mt * 128;
  }
  f32x16 acc[2][2];
  for (int i = 0; i < 2; ++i) for (int j = 0; j < 2; ++j) acc[i][j] = zero16();
  gemm_main<2>(A, lda, Bt, lda, K, acc, sA, sB);
#pragma unroll
  for (int mi = 0; mi < 2; ++mi)
#pragma unroll
    for (int ni = 0; ni < 2; ++ni) {
      const int col = nt * 128 + wn * 64 + ni * 32 + l31, rb = rowbase + wm * 64 + mi * 32;
#pragma unroll
      for (int r = 0; r < 16; ++r) F[(size_t)(rb + crow(r, h)) * 512 + col] = f2bf(acc[mi][ni][r]);
    }
}

DI void fnw_tile(const Params& p, int l, int t, unsigned char* smem) {
  unsigned char* const WS_ = launder_ptr(p.ws);
  const int tid = opaque_tid(), lane = tid & 63, wv = tid >> 6, wm = wv >> 1, wn = wv & 1, l31 = lane & 31, h = lane >> 5;
  bfr* sA = (bfr*)smem; bfr* sB = sA + 128 * 72;
  const int mt = t >> 2, nt = t & 3, m0 = mt * 128, n0 = nt * 128;
  const bfr* F = (const bfr*)(WS_ + O_F);
  const bfr* W = (const bfr*)(WS_ + O_FNW) + (size_t)l * 512 * 512;
  const bfr* P = (const bfr*)(WS_ + O_P);
  bfr* YS = (bfr*)(WS_ + O_YS);
  f32x16 acc[2][2];
  for (int i = 0; i < 2; ++i) for (int j = 0; j < 2; ++j) acc[i][j] = zero16();
  gemm_main<2>(F + (size_t)m0 * 512, 512, W + (size_t)n0 * 512, 512, 512, acc, sA, sB);
#pragma unroll
  for (int mi = 0; mi < 2; ++mi)
#pragma unroll
    for (int ni = 0; ni < 2; ++ni) {
      const int col = n0 + wn * 64 + ni * 32 + l31, rb = m0 + wm * 64 + mi * 32;
      const float bias = p.fn_b[l * 512 + col];
#pragma unroll
      for (int r = 0; r < 16; ++r) {
        const size_t row = rb + crow(r, h);
        const float z = bf2f(P[row * PLD + C_FNZ + col]);
        YS[row * DM + col] = f2bf((acc[mi][ni][r] + bias) * siluf_(z));
      }
    }
}

DI void stream_of(int n, int cpc, int& m, int& T, int& soff) { if (n < cpc) { m = n; T = CTX; soff = 0; } else { m = n - cpc; T = SEQ; soff = CTX; } }

DI void dn_prep_unit(const Params& p, int l, int unit, unsigned char* smem) {
  unsigned char* const WS_ = launder_ptr(p.ws);
  const int tid = opaque_tid(), lane = tid & 63, wv = tid >> 6, l31 = lane & 31, h = lane >> 5;
  const int n = unit % 68, hd = (unit / 68) & 3, b = (unit / 272) & 3, dir = unit / 1088;
  int m, T, soff; stream_of(n, 4, m, T, soff);
  bfr* sK = (bfr*)smem;
  bfr* sQ = (bfr*)(smem + 17408);
  bfr* sVbT = (bfr*)(smem + 34816);
  bfr* sKbT = (bfr*)(smem + 53248);
  float* sgc = (float*)(smem + 71680);
  float* sbeta = sgc + 64;
  float* sAm = (float*)smem;
  bfr* sT = (bfr*)(smem + 17408);
  const bfr* P = (const bfr*)(WS_ + O_P);
  const float* AB = (const float*)(WS_ + O_AB);
  bfr* U = (bfr*)(WS_ + O_DNU) + (size_t)unit * DN_USZ;
  bfr* g_wneg = U; bfr* g_qdec = U + 8192; bfr* g_kdT = U + 16384; bfr* g_aqk = U + 24576; bfr* g_u = U + 28672;
  const int rowbase = b * SP + soff;
  __syncthreads();
  if (wv == 0) {
    const int pos = 64 * m + lane, t = dir ? T - 1 - pos : pos;
    const size_t row = rowbase + t;
    const float a = AB[row * 16 + dir * 4 + hd], bb = AB[row * 16 + 8 + dir * 4 + hd];
    const float xa = a + p.dn_dt_bias[(l * 2 + dir) * 4 + hd];
    const float sp = xa > 20.f ? xa : log1pf(__expf(xa));
    float g = -__expf(p.dn_a_log[(l * 2 + dir) * 4 + hd]) * sp;
#pragma unroll
    for (int o = 1; o < 64; o <<= 1) { const float u = __shfl_up(g, o); if (lane >= o) g += u; }
    sgc[lane] = g; sbeta[lane] = sigmoidf_(bb);
  }
  __syncthreads();
  {
    const int i = tid >> 2, cq = tid & 3;
    const int pos = 64 * m + i, t = dir ? T - 1 - pos : pos;
    const size_t row = rowbase + t;
    const float gci = sgc[i], bet = sbeta[i], gl = sgc[63];
    const float egc = __expf(gci), ekd = __expf(gl - gci);
    const bool hp = t > 0, hn = t < T - 1;
#pragma unroll
    for (int ten = 0; ten < 3; ++ten) {
      float val[32]; float ss = 0.f;
      const int cbase = ten * 512 + hd * 128 + cq * 32;
      const bfr* src = P + row * PLD + C_DNQ + cbase;
      const float* cw = p.dn_conv + (size_t)l * 3 * 1536 + cbase;
#pragma unroll
      for (int c8 = 0; c8 < 4; ++c8) {
        const bf16x8 cur = ld16(src + 8 * c8);
        bf16x8 prv, nxt;
        for (int j = 0; j < 8; ++j) { prv[j] = 0; nxt[j] = 0; }
        if (hp) prv = ld16(src - PLD + 8 * c8);
        if (hn) nxt = ld16(src + PLD + 8 * c8);
#pragma unroll
        for (int j = 0; j < 8; ++j) {
          const int ch = 8 * c8 + j;
          const float y = cw[ch] * bf2f((bfr)prv[j]) + cw[1536 + ch] * bf2f((bfr)cur[j]) + cw[3072 + ch] * bf2f((bfr)nxt[j]);
          const float sv = siluf_(y);
          val[ch] = sv; ss += sv * sv;
        }
      }
      ss += __shfl_xor(ss, 1); ss += __shfl_xor(ss, 2);
      if (ten == 0) {
        const float sc = rsqrtf(ss + EPS) * 0.08838834764831845f;
#pragma unroll
        for (int c8 = 0; c8 < 4; ++c8) {
          u32x4 w1, w2;
#pragma unroll
          for (int q = 0; q < 4; ++q) {
            const float x0 = val[8 * c8 + 2 * q] * sc, x1 = val[8 * c8 + 2 * q + 1] * sc;
            w1[q] = pk2(x0, x1); w2[q] = pk2(x0 * egc, x1 * egc);
          }
          *(u32x4*)(sQ + i * 136 + cq * 32 + 8 * c8) = w1;
          { u32x2 lo2, hi2; lo2[0] = w2[0]; lo2[1] = w2[1]; hi2[0] = w2[2]; hi2[1] = w2[3];
            *(u32x2*)(g_qdec + fragp_idx(i, cq * 32 + 8 * c8, 4)) = lo2;
            *(u32x2*)(g_qdec + fragp_idx(i, cq * 32 + 8 * c8 + 4, 4)) = hi2; }
        }
      } else if (ten == 1) {
        const float sc = rsqrtf(ss + EPS);
#pragma unroll
        for (int c8 = 0; c8 < 4; ++c8) {
          u32x4 w1;
#pragma unroll
          for (int q = 0; q < 4; ++q) w1[q] = pk2(val[8 * c8 + 2 * q] * sc, val[8 * c8 + 2 * q + 1] * sc);
          *(u32x4*)(sK + i * 136 + cq * 32 + 8 * c8) = w1;
        }
#pragma unroll
        for (int ch = 0; ch < 32; ++ch) {
          const float kn = val[ch] * sc;
          sKbT[(cq * 32 + ch) * 72 + i] = f2bf(kn * bet * egc);
          g_kdT[fragp_idx(cq * 32 + ch, i, 2)] = f2bf(kn * ekd);
        }
      } else {
#pragma unroll
        for (int ch = 0; ch < 32; ++ch) sVbT[(cq * 32 + ch) * 72 + i] = f2bf(val[ch] * bet);
      }
    }
    if (tid == 0) ((float*)(WS_ + O_DNG))[unit] = __expf(gl);
  }
  __syncthreads();
  f32x16 kk = zero16(), qk = zero16();
  const int qi = wv >> 1, qj = wv & 1;
#pragma unroll
  for (int s = 0; s < 8; ++s) {
    const bf16x8 bk = ld16(sK + (32 * qj + l31) * 136 + 16 * s + 8 * h);
    const bf16x8 ak = ld16(sK + (32 * qi + l31) * 136 + 16 * s + 8 * h);
    const bf16x8 aq = ld16(sQ + (32 * qi + l31) * 136 + 16 * s + 8 * h);
    kk = MFMA(ak, bk, kk); qk = MFMA(aq, bk, qk);
  }
  __syncthreads();
  {
    const int j = 32 * qj + l31;
    const float gcj = sgc[j];
#pragma unroll
    for (int r = 0; r < 16; ++r) {
      const int i = 32 * qi + crow(r, h);
      const float dec = i >= j ? __expf(sgc[i] - gcj) : 0.f;
      sAm[i * 65 + j] = i > j ? sbeta[i] * kk[r] * dec : 0.f;
      g_aqk[fragp_idx(i, j, 2)] = f2bf(i >= j ? qk[r] * dec : 0.f);
    }
  }
  __syncthreads();
  if (wv == 0) {
    float Tc[64];
#pragma unroll
    for (int i = 0; i < 64; ++i) {
      const float arow = sAm[i * 65 + lane];
      float a = (i == lane) ? 1.f : 0.f, a2 = 0.f;
#pragma unroll
      for (int j = 0; j < i; ++j) {
        const float av = __uint_as_float(__builtin_amdgcn_readlane(__float_as_uint(arow), j));
        if (j & 1) a2 -= av * Tc[j]; else a -= av * Tc[j];
      }
      Tc[i] = a + a2;
      __builtin_amdgcn_sched_barrier(0);
    }
#pragma unroll
    for (int i = 0; i < 64; ++i) sT[i * 72 + lane] = f2bf(Tc[i]);
  }
  __syncthreads();
#pragma unroll
  for (int q = 0; q < 4; ++q) {
    const int tt = wv * 4 + q, which = tt >> 3, mb = (tt >> 2) & 1, nb = tt & 3;
    const bfr* Bs = which ? sKbT : sVbT;
    f32x16 a = zero16();
#pragma unroll
    for (int s = 0; s < 4; ++s) a = MFMA(ld16(sT + (32 * mb + l31) * 72 + 16 * s + 8 * h), ld16(Bs + (32 * nb + l31) * 72 + 16 * s + 8 * h), a);
    if (which) {
#pragma unroll
      for (int r = 0; r < 16; ++r) g_wneg[fragp_idx(32 * mb + crow(r, h), 32 * nb + l31, 4)] = f2bf(-a[r]);
    } else {
      u32x4 w0, w1;
#pragma unroll
      for (int q2 = 0; q2 < 4; ++q2) { w0[q2] = pk2(a[2 * q2], a[2 * q2 + 1]); w1[q2] = pk2(a[8 + 2 * q2], a[8 + 2 * q2 + 1]); }
      bfr* d = g_u + ((mb * 4 + nb) * 64 + lane) * 16;
      *(u32x4*)d = w0; *(u32x4*)(d + 8) = w1;
    }
  }
}

DI void hg_prep_unit(const Params& p, int l, int unit, unsigned char* smem) {
  unsigned char* const WS_ = launder_ptr(p.ws);
  const int tid = opaque_tid(), lane = tid & 63, wv = tid >> 6, l31 = lane & 31, h = lane >> 5;
  const int n = unit % 136, hd = (unit / 136) & 3, b = (unit / 544) & 3, dir = unit / 2176;
  int m, T, soff; stream_of(n, 8, m, T, soff);
  bfr* sQt = (bfr*)smem;
  bfr* sKt = (bfr*)(smem + 8704);
  bfr* sVT = (bfr*)(smem + 17408);
  const bfr* P = (const bfr*)(WS_ + O_P);
  bfr* U = (bfr*)(WS_ + O_HGU) + (size_t)unit * HG_USZ;
  bfr* g_qhat = U; bfr* g_khT = U + 4096; bfr* g_vT = U + 8192;
  float* OHG = (float*)(WS_ + O_OHG) + (size_t)dir * NTOK * 512;
  const int rowbase = b * SP + soff;
  float* sTot = (float*)(smem + 27648);
  __syncthreads();
  {
    const int dk = tid & 127, hf = tid >> 7, i0 = 16 * hf;
    const float lbv = ((const float*)(WS_ + O_LB))[(l * 2 + dir) * 512 + hd * 128 + dk];
    float G[16], KK[16], Q[16];
    unsigned vv[8];
#pragma unroll
    for (int i = 0; i < 16; ++i) {
      const int pos = 32 * m + i0 + i, t = dir ? T - 1 - pos : pos;
      const size_t row = rowbase + t;
      KK[i] = bf2f(P[row * PLD + C_HGF + dir * 512 + hd * 128 + dk]);
      Q[i] = bf2f(P[row * PLD + C_HGQ + hd * 128 + dk]);
      const unsigned x = P[row * PLD + C_HGI + hd * 128 + dk];
      if (i & 1) vv[i >> 1] |= x << 16; else vv[i >> 1] = x;
    }
    float cum = 0.f;
#pragma unroll
    for (int i = 0; i < 16; ++i) {
      const float kkv = fminf((1.f - lbv) * sigmoidf_(-KK[i]), 0.9999999f);
      KK[i] = kkv;
      cum += log1pf(-kkv);
      G[i] = cum;
    }
    sTot[hf * 128 + dk] = cum;
#pragma unroll
    for (int q = 0; q < 2; ++q) {
      u32x4 w; w[0] = vv[4 * q]; w[1] = vv[4 * q + 1]; w[2] = vv[4 * q + 2]; w[3] = vv[4 * q + 3];
      *(u32x4*)(g_vT + fragn_idx(dk, i0 + 8 * q, 2)) = w;
      *(u32x4*)(sVT + dk * 40 + i0 + 8 * q) = w;
    }
    __syncthreads();
    const float t0 = sTot[dk], t1 = sTot[128 + dk];
    const float Gl = t0 + t1, Gr = t0, goff = hf ? t0 : 0.f;
    unsigned kh[8];
#pragma unroll
    for (int i = 0; i < 16; ++i) {
      const int ig = i0 + i;
      const float Gi = G[i] + goff;
      const float kkv = KK[i];
      const float q = siluf_(Q[i]);
      g_qhat[fragp_idx(ig, dk, 4)] = f2bf(q * __expf(Gi));
      const float khv = kkv * __expf(Gl - Gi);
      if (i & 1) kh[i >> 1] |= ((unsigned)f2bf(khv)) << 16; else kh[i >> 1] = f2bf(khv);
      sQt[ig * 136 + dk] = f2bf(q * __expf(fminf(Gi - Gr, 80.f)));
      sKt[ig * 136 + dk] = f2bf(kkv * __expf(fminf(Gr - Gi, 80.f)));
    }
#pragma unroll
    for (int q = 0; q < 2; ++q) { u32x4 w; w[0] = kh[4 * q]; w[1] = kh[4 * q + 1]; w[2] = kh[4 * q + 2]; w[3] = kh[4 * q + 3]; *(u32x4*)(g_khT + fragn_idx(dk, i0 + 8 * q, 2)) = w; }
    if (hf == 0) ((float*)(WS_ + O_HGD))[(size_t)unit * 128 + dk] = __expf(Gl);
  }
  __syncthreads();
  f32x16 at = zero16();
#pragma unroll
  for (int s = 0; s < 8; ++s) at = MFMA(ld16(sKt + l31 * 136 + 16 * s + 8 * h), ld16(sQt + l31 * 136 + 16 * s + 8 * h), at);
#pragma unroll
  for (int r = 0; r < 16; ++r) at[r] = (crow(r, h) <= l31) ? at[r] : 0.f;
  const bf16x8 a0 = pack8<0>(at), a1 = pack8<1>(at);
  f32x16 o = zero16();
  o = MFMA(ld2x8(sVT + (32 * wv + l31) * 40 + 4 * h), a0, o);
  o = MFMA(ld2x8(sVT + (32 * wv + l31) * 40 + 16 + 4 * h), a1, o);
  {
    const int pos = 32 * m + l31, t = dir ? T - 1 - pos : pos;
    float* dst = OHG + (size_t)(rowbase + t) * 512 + hd * 128 + 32 * wv + 4 * h;
#pragma unroll
    for (int g = 0; g < 4; ++g) { f32x4 w; w[0] = o[4 * g]; w[1] = o[4 * g + 1]; w[2] = o[4 * g + 2]; w[3] = o[4 * g + 3]; *(f32x4*)(dst + 8 * g) = w; }
  }
}

DI void unpack16(const bfr* p, f32x16& v) {
  const bf16x8 a = ld16(p), b = ld16(p + 8);
#pragma unroll
  for (int e = 0; e < 8; ++e) { v[e] = bf2f((bfr)a[e]); v[8 + e] = bf2f((bfr)b[e]); }
}
DI void dn_scan_block(const Params& p, int chain_in, unsigned char* smem) {
  int chain = blockIdx.x; asm volatile("" : "+v"(chain)); chain = __builtin_amdgcn_readfirstlane(chain) - chain_in;
  unsigned char* const WS_ = launder_ptr(p.ws);
  const int tid = opaque_tid(), lane = tid & 63, sl = tid >> 6, l31 = lane & 31, h = lane >> 5;
  const int hd = chain & 3, b = (chain >> 2) & 3, dir = chain >> 4;
  float* ODN = (float*)(WS_ + O_ODN) + (size_t)dir * NTOK * 512;
  const float* GL = (const float*)(WS_ + O_DNG);
  bfr* sU = (bfr*)smem;
  const bfr *s_wneg = sU, *s_qdec = sU + 8192, *s_kdT = sU + 16384, *s_aqk = sU + 24576, *s_u = sU + 28672;
  const u32x4* src = (const u32x4*)(WS_ + O_DNU) + (size_t)chain * 68 * 4608;
  u32x4 st[18];
#pragma unroll
  for (int i = 0; i < 18; ++i) st[i] = src[tid + 256 * i];
  f32x16 S[4];
  for (int i = 0; i < 4; ++i) S[i] = zero16();
#pragma unroll 1
  for (int n = 0; n < 68; ++n) {
    __syncthreads();
#pragma unroll
    for (int i = 0; i < 18; ++i) ((u32x4*)sU)[tid + 256 * i] = st[i];
    __syncthreads();
    if (n + 1 < 68) {
#pragma unroll
      for (int i = 0; i < 18; ++i) st[i] = src[(size_t)(n + 1) * 4608 + tid + 256 * i];
    }
    const float gl = GL[chain * 68 + n];
    int m, T, soff; stream_of(n, 4, m, T, soff);
    f32x16 vn[2];
#pragma unroll
    for (int mb = 0; mb < 2; ++mb) {
      unpack16(s_u + ((mb * 4 + sl) * 64 + lane) * 16, vn[mb]);
#pragma unroll
      for (int k = 0; k < 4; ++k) {
        vn[mb] = MFMA(ld16(s_wneg + (((mb * 4 + k) * 2 + 0) * 64 + lane) * 8), pack8<0>(S[k]), vn[mb]);
        vn[mb] = MFMA(ld16(s_wneg + (((mb * 4 + k) * 2 + 1) * 64 + lane) * 8), pack8<1>(S[k]), vn[mb]);
      }
    }
    __builtin_amdgcn_sched_barrier(0);
    bf16x8 vp[2][2];
#pragma unroll
    for (int jb = 0; jb < 2; ++jb) { vp[jb][0] = pack8<0>(vn[jb]); vp[jb][1] = pack8<1>(vn[jb]); }
    __builtin_amdgcn_sched_barrier(0);
#pragma unroll
    for (int mb = 0; mb < 2; ++mb) {
      f32x16 o = zero16();
#pragma unroll
      for (int k = 0; k < 4; ++k) {
        o = MFMA(ld16(s_qdec + (((mb * 4 + k) * 2 + 0) * 64 + lane) * 8), pack8<0>(S[k]), o);
        o = MFMA(ld16(s_qdec + (((mb * 4 + k) * 2 + 1) * 64 + lane) * 8), pack8<1>(S[k]), o);
      }
#pragma unroll
      for (int jb = 0; jb < 2; ++jb)
#pragma unroll
        for (int s = 0; s < 2; ++s) o = MFMA(ld16(s_aqk + (((mb * 2 + jb) * 2 + s) * 64 + lane) * 8), vp[jb][s], o);
#pragma unroll
      for (int r = 0; r < 16; ++r) {
        const int pos = 64 * m + 32 * mb + crow(r, h), t = dir ? T - 1 - pos : pos;
        ODN[(size_t)(b * SP + soff + t) * 512 + hd * 128 + 32 * sl + l31] = o[r];
      }
      __builtin_amdgcn_sched_barrier(0);
    }
#pragma unroll
    for (int k = 0; k < 4; ++k) {
#pragma unroll
      for (int r = 0; r < 16; ++r) S[k][r] *= gl;
#pragma unroll
      for (int jb = 0; jb < 2; ++jb)
#pragma unroll
        for (int s = 0; s < 2; ++s) S[k] = MFMA(ld16(s_kdT + (((k * 2 + jb) * 2 + s) * 64 + lane) * 8), vp[jb][s], S[k]);
    }
  }
}

DI void hg_scan_block(const Params& p, int chain_in, unsigned char* smem) {
  int chain = blockIdx.x; asm volatile("" : "+v"(chain)); chain = __builtin_amdgcn_readfirstlane(chain) - chain_in;
  unsigned char* const WS_ = launder_ptr(p.ws);
  const int tid = opaque_tid(), lane = tid & 63, sl = tid >> 6, l31 = lane & 31, h = lane >> 5;
  const int hd = chain & 3, b = (chain >> 2) & 3, dir = chain >> 4;
  float* OHG = (float*)(WS_ + O_OHG) + (size_t)dir * NTOK * 512;
  bfr* sU = (bfr*)smem;
  const bfr *s_qhat = sU, *s_khT = sU + 4096, *s_vT = sU + 8192;
  float* s_ds = (float*)(smem + 24576);
  const u32x4* src = (const u32x4*)(WS_ + O_HGU) + (size_t)chain * 136 * 1536;
  const float* dsg = (const float*)(WS_ + O_HGD) + (size_t)chain * 136 * 128;
  u32x4 st[6]; float dsr;
#pragma unroll
  for (int i = 0; i < 6; ++i) st[i] = src[tid + 256 * i];
  dsr = dsg[tid & 127];
  float oc[16];
  {
    int m0_, T0_, so0_; stream_of(0, 8, m0_, T0_, so0_);
#pragma unroll
    for (int r = 0; r < 16; ++r) {
      const int pos = 32 * m0_ + crow(r, h), t = dir ? T0_ - 1 - pos : pos;
      oc[r] = OHG[(size_t)(b * SP + so0_ + t) * 512 + hd * 128 + 32 * sl + l31];
    }
  }
  f32x16 S[4];
  for (int i = 0; i < 4; ++i) S[i] = zero16();
#pragma unroll 1
  for (int n = 0; n < 136; ++n) {
    __syncthreads();
#pragma unroll
    for (int i = 0; i < 6; ++i) ((u32x4*)sU)[tid + 256 * i] = st[i];
    if (tid < 128) s_ds[tid] = dsr;
    __syncthreads();
    if (n + 1 < 136) {
#pragma unroll
      for (int i = 0; i < 6; ++i) st[i] = src[(size_t)(n + 1) * 1536 + tid + 256 * i];
      dsr = dsg[(size_t)(n + 1) * 128 + (tid & 127)];
    }
    float on[16];
    if (n + 1 < 136) {
      int m1_, T1_, so1_; stream_of(n + 1, 8, m1_, T1_, so1_);
#pragma unroll
      for (int r = 0; r < 16; ++r) {
        const int pos = 32 * m1_ + crow(r, h), t = dir ? T1_ - 1 - pos : pos;
        on[r] = OHG[(size_t)(b * SP + so1_ + t) * 512 + hd * 128 + 32 * sl + l31];
      }
    } else {
#pragma unroll
      for (int r = 0; r < 16; ++r) on[r] = 0.f;
    }
    int m, T, soff; stream_of(n, 8, m, T, soff);
    f32x16 o = zero16();
#pragma unroll
    for (int k = 0; k < 4; ++k) {
      o = MFMA(ld16(s_qhat + ((k * 2 + 0) * 64 + lane) * 8), pack8<0>(S[k]), o);
      o = MFMA(ld16(s_qhat + ((k * 2 + 1) * 64 + lane) * 8), pack8<1>(S[k]), o);
    }
#pragma unroll
    for (int r = 0; r < 16; ++r) {
      const int pos = 32 * m + crow(r, h), t = dir ? T - 1 - pos : pos;
      float* dst = OHG + (size_t)(b * SP + soff + t) * 512 + hd * 128 + 32 * sl + l31;
      *dst = oc[r] + o[r];
    }
    const bf16x8 v0 = ld16(s_vT + ((sl * 2 + 0) * 64 + lane) * 8), v1 = ld16(s_vT + ((sl * 2 + 1) * 64 + lane) * 8);
#pragma unroll
    for (int k = 0; k < 4; ++k) {
#pragma unroll
      for (int g = 0; g < 4; ++g) {
        const f32x4 d4 = *(const f32x4*)(s_ds + 32 * k + 8 * g + 4 * h);
        S[k][4 * g] *= d4[0]; S[k][4 * g + 1] *= d4[1]; S[k][4 * g + 2] *= d4[2]; S[k][4 * g + 3] *= d4[3];
      }
      S[k] = MFMA(ld16(s_khT + ((k * 2 + 0) * 64 + lane) * 8), v0, S[k]);
      S[k] = MFMA(ld16(s_khT + ((k * 2 + 1) * 64 + lane) * 8), v1, S[k]);
    }
#pragma unroll
    for (int r = 0; r < 16; ++r) oc[r] = on[r];
  }
}

DI void attn_unit(const Params& p, int l, int unit, unsigned char* smem) {
  unsigned char* const WS_ = launder_ptr(p.ws);
  const int tid = opaque_tid(), lane = tid & 63, wv = tid >> 6, l31 = lane & 31, h = lane >> 5;
  int b, hd, q0, nkeys;
  if (unit < 512) { b = unit >> 7; hd = (unit >> 5) & 3; q0 = CTX + (unit & 31) * 128; nkeys = SP; }
  else { const int u = unit - 512; b = u >> 3; hd = (u >> 1) & 3; q0 = (u & 1) * 128; nkeys = CTX; }
  bfr* sK = (bfr*)smem;
  bfr* sVT = (bfr*)(smem + 17408);
  const bfr* P = (const bfr*)(WS_ + O_P);
  const bfr* VT = (const bfr*)(WS_ + O_VT) + ((size_t)(b * 4 + hd) * 128) * SP;
  const float lam = ((const float*)(WS_ + O_LAM))[l];
  const float lam_init = 0.8f - 0.6f * expf(-0.3f * (float)l);
  const float cs = 0.125f * 1.4426950408889634f;
  const size_t rowq = (size_t)b * SP + q0 + wv * 32 + l31;
  bf16x8 qf[2][4];
#pragma unroll
  for (int mp = 0; mp < 2; ++mp)
#pragma unroll
    for (int s = 0; s < 4; ++s) qf[mp][s] = ld16(P + rowq * PLD + C_DAQ + hd * 128 + mp * 64 + 16 * s + 8 * h);
  const bfr* Kbase = P + (size_t)b * SP * PLD + C_DAK + hd * 128;
  float mx[2] = {-1e30f, -1e30f}, ls[2] = {0.f, 0.f};
  const int ntile = nkeys >> 6;
  u32x4 rk[4], rv[4];
#pragma unroll
  for (int i = 0; i < 4; ++i) { const int c = tid + 256 * i, key = c >> 4, kc = c & 15; rk[i] = *(const u32x4*)(Kbase + (size_t)key * PLD + 8 * kc); }
  for (int kt = 0; kt < ntile; ++kt) {
    __syncthreads();
#pragma unroll
    for (int i = 0; i < 4; ++i) { const int c = tid + 256 * i, key = c >> 4, kc = c & 15; *(u32x4*)(sK + key * 136 + 8 * kc) = rk[i]; }
    __syncthreads();
    if (kt + 1 < ntile) {
#pragma unroll
      for (int i = 0; i < 4; ++i) { const int c = tid + 256 * i, key = c >> 4, kc = c & 15; rk[i] = *(const u32x4*)(Kbase + (size_t)((kt + 1) * 64 + key) * PLD + 8 * kc); }
    }
#pragma unroll
    for (int kb = 0; kb < 2; ++kb)
#pragma unroll
      for (int mp = 0; mp < 2; ++mp) {
        f32x16 st = zero16();
#pragma unroll
        for (int s = 0; s < 4; ++s) st = MFMA(ld16(sK + (32 * kb + l31) * 136 + mp * 64 + 16 * s + 8 * h), qf[mp][s], st);
        float tm = st[0];
#pragma unroll
        for (int r = 1; r < 16; ++r) tm = fmaxf(tm, st[r]);
        const float mn = fmaxf(mx[mp], tm);
        const float nmc = -mn * cs;
        float sum = 0.f;
#pragma unroll
        for (int r = 0; r < 16; ++r) sum += __builtin_amdgcn_exp2f(fmaf(st[r], cs, nmc));
        ls[mp] = ls[mp] * __builtin_amdgcn_exp2f((mx[mp] - mn) * cs) + sum;
        mx[mp] = mn;
      }
  }
  float nm[2], sc[2];
#pragma unroll
  for (int mp = 0; mp < 2; ++mp) {
    const float mo = __shfl_xor(mx[mp], 32), lo = __shfl_xor(ls[mp], 32);
    const float M = fmaxf(mx[mp], mo);
    const float L = ls[mp] * __builtin_amdgcn_exp2f((mx[mp] - M) * cs) + lo * __builtin_amdgcn_exp2f((mo - M) * cs);
    nm[mp] = -M * cs; sc[mp] = (mp ? lam : 1.f) / L;
  }
  f32x16 oacc[4];
  for (int i = 0; i < 4; ++i) oacc[i] = zero16();
#pragma unroll
  for (int i = 0; i < 4; ++i) {
    const int c = tid + 256 * i;
    { const int key = c >> 4, kc = c & 15; rk[i] = *(const u32x4*)(Kbase + (size_t)key * PLD + 8 * kc); }
    { const int dv = c >> 3, kc = c & 7; rv[i] = *(const u32x4*)(VT + (size_t)dv * SP + 8 * kc); }
  }
  for (int kt = 0; kt < ntile; ++kt) {
    __syncthreads();
#pragma unroll
    for (int i = 0; i < 4; ++i) {
      const int c = tid + 256 * i;
      { const int key = c >> 4, kc = c & 15; *(u32x4*)(sK + key * 136 + 8 * kc) = rk[i]; }
      { const int dv = c >> 3, kc = c & 7; *(u32x4*)(sVT + dv * 72 + 8 * kc) = rv[i]; }
    }
    __syncthreads();
    if (kt + 1 < ntile) {
#pragma unroll
      for (int i = 0; i < 4; ++i) {
        const int c = tid + 256 * i;
        { const int key = c >> 4, kc = c & 15; rk[i] = *(const u32x4*)(Kbase + (size_t)((kt + 1) * 64 + key) * PLD + 8 * kc); }
        { const int dv = c >> 3, kc = c & 7; rv[i] = *(const u32x4*)(VT + (size_t)dv * SP + (kt + 1) * 64 + 8 * kc); }
      }
    }
#pragma unroll 1
    for (int kb = 0; kb < 2; ++kb) {
      f32x16 s0 = zero16(), s1 = zero16();
#pragma unroll
      for (int s = 0; s < 4; ++s) {
        s0 = MFMA(ld16(sK + (32 * kb + l31) * 136 + 16 * s + 8 * h), qf[0][s], s0);
        s1 = MFMA(ld16(sK + (32 * kb + l31) * 136 + 64 + 16 * s + 8 * h), qf[1][s], s1);
      }
#pragma unroll
      for (int r = 0; r < 16; ++r) s0[r] = __builtin_amdgcn_exp2f(fmaf(s0[r], cs, nm[0])) * sc[0] - __builtin_amdgcn_exp2f(fmaf(s1[r], cs, nm[1])) * sc[1];
      const bf16x8 p0 = pack8<0>(s0), p1 = pack8<1>(s0);
#pragma unroll
      for (int dvb = 0; dvb < 4; ++dvb) {
        oacc[dvb] = MFMA(ld2x8(sVT + (32 * dvb + l31) * 72 + 32 * kb + 4 * h), p0, oacc[dvb]);
        oacc[dvb] = MFMA(ld2x8(sVT + (32 * dvb + l31) * 72 + 32 * kb + 16 + 4 * h), p1, oacc[dvb]);
      }
    }
  }
  float ss = 0.f;
#pragma unroll
  for (int dvb = 0; dvb < 4; ++dvb)
#pragma unroll
    for (int r = 0; r < 16; ++r) ss += oacc[dvb][r] * oacc[dvb][r];
  ss += __shfl_xor(ss, 32);
  const float rs = rsqrtf(ss * (1.f / 128.f) + EPS) * (1.f - lam_init);
  bfr* YS = (bfr*)(WS_ + O_YS);
#pragma unroll
  for (int dvb = 0; dvb < 4; ++dvb)
#pragma unroll
    for (int g = 0; g < 4; ++g) {
      const int dv = 32 * dvb + 8 * g + 4 * h;
      const s16x4 z4 = *(const s16x4*)(P + rowq * PLD + C_DAZ + hd * 128 + dv);
      const f32x4 gn = *(const f32x4*)(p.da_norm + l * 128 + dv);
      float y[4];
      for (int q = 0; q < 4; ++q) y[q] = oacc[dvb][4 * g + q] * rs * gn[q] * siluf_(bf2f((bfr)z4[q]));
      u32x2 w; w[0] = pk2(y[0], y[1]); w[1] = pk2(y[2], y[3]);
      *(u32x2*)(YS + rowq * DM + 1536 + hd * 128 + dv) = w;
    }
}

DI void phase_finalize(const Params& p, int l) {
  unsigned char* const WS_ = launder_ptr(p.ws);
  const int tid_ = opaque_tid(), lane = tid_ & 63, gw = blockIdx.x * 4 + (tid_ >> 6), nw = gridDim.x * 4;
  const bfr* P = (const bfr*)(WS_ + O_P);
  bfr* YS = (bfr*)(WS_ + O_YS);
  for (int it = gw; it < 2 * NTOK; it += nw) {
    const int br = it & 1; const size_t row = it >> 1;
    if (l == 3 && (int)(row % SP) < CTX) continue;
    const float* O0 = (const float*)(WS_ + (br ? O_OHG : O_ODN)) + row * 512 + lane * 8;
    const float* O1 = O0 + (size_t)NTOK * 512;
    const float* nrm = (br ? p.hg_norm : p.dn_norm) + l * 128 + (lane & 15) * 8;
    const int zc = (br ? C_HGZ : C_DNZ) + lane * 8;
    float o[8]; float ss = 0.f;
    const f32x4 a0 = *(const f32x4*)O0, a1 = *(const f32x4*)(O0 + 4), b0 = *(const f32x4*)O1, b1 = *(const f32x4*)(O1 + 4);
    for (int q = 0; q < 4; ++q) { o[q] = a0[q] + b0[q]; o[4 + q] = a1[q] + b1[q]; }
    for (int q = 0; q < 8; ++q) ss += o[q] * o[q];
    ss += __shfl_xor(ss, 1); ss += __shfl_xor(ss, 2); ss += __shfl_xor(ss, 4); ss += __shfl_xor(ss, 8);
    const float rs = rsqrtf(ss * (1.f / 128.f) + EPS);
    const bf16x8 z = ld16(P + row * PLD + zc);
    u32x4 w;
    for (int q = 0; q < 4; ++q) {
      const float y0 = o[2 * q] * rs * nrm[2 * q] * siluf_(bf2f((bfr)z[2 * q]));
      const float y1 = o[2 * q + 1] * rs * nrm[2 * q + 1] * siluf_(bf2f((bfr)z[2 * q + 1]));
      w[q] = pk2(y0, y1);
    }
    *(u32x4*)(YS + row * DM + (br ? 1024 : 512) + lane * 8) = w;
  }
}

DI void phase_merge(const Params& p, int l, unsigned char* smem) {
  unsigned char* const WS_ = launder_ptr(p.ws);
  const int tid = opaque_tid(), lane = tid & 63, wv = tid >> 6, wm = wv >> 1, wn = wv & 1, l31 = lane & 31, h = lane >> 5;
  bfr* sA = (bfr*)smem; bfr* sB = sA + 128 * 72;
  const bfr* YS = (const bfr*)(WS_ + O_YS);
  const bfr* P = (const bfr*)(WS_ + O_P);
  bfr* Y = (bfr*)(WS_ + O_Y);
  for (int it = 0;; ++it) {
    int mt, nt;
    if (!tile_order(it, 136, 16, 34, 4, mt, nt)) break;
    const int m0 = mt * 128, n0 = nt * 128;
    if (l == 3 && (m0 % SP) < CTX) continue;
    f32x16 tot[2][2];
    for (int i = 0; i < 2; ++i) for (int j = 0; j < 2; ++j) tot[i][j] = zero16();
#pragma unroll 1
    for (int nb = 0; nb < 4; ++nb) {
      f32x16 acc[2][2];
      for (int i = 0; i < 2; ++i) for (int j = 0; j < 2; ++j) acc[i][j] = zero16();
      gemm_main<2>(YS + (size_t)m0 * DM + nb * 512, DM, (const bfr*)(WS_ + O_WBR) + ((size_t)(l * 4 + nb) * 2048 + n0) * 512, 512, 512, acc, sA, sB);
#pragma unroll
      for (int mi = 0; mi < 2; ++mi)
#pragma unroll
        for (int ni = 0; ni < 2; ++ni) {
          int rbo = m0 + wm * 64 + mi * 32 + 4 * h;
          asm volatile("" : "+v"(rbo));
          const bfr* gp = P + (size_t)rbo * PLD + C_GATE + nb * 2048 + n0 + wn * 64 + ni * 32 + l31;
#pragma unroll
          for (int r = 0; r < 16; ++r) {
            const float g = bf2f(gp[(size_t)((r & 3) + 8 * (r >> 2)) * PLD]);
            tot[mi][ni][r] += sigmoidf_(g) * acc[mi][ni][r];
          }
          __builtin_amdgcn_sched_barrier(0);
        }
    }
#pragma unroll
    for (int mi = 0; mi < 2; ++mi)
#pragma unroll
      for (int ni = 0; ni < 2; ++ni) {
        const int col = n0 + wn * 64 + ni * 32 + l31, rb = m0 + wm * 64 + mi * 32;
#pragma unroll
        for (int r = 0; r < 16; ++r) Y[(size_t)(rb + crow(r, h)) * DM + col] = f2bf(tot[mi][ni][r]);
      }
  }
}

DI void phase_out(const Params& p, int l, unsigned char* smem) {
  unsigned char* const WS_ = launder_ptr(p.ws);
  const int tid = opaque_tid(), lane = tid & 63, wv = tid >> 6, wm = wv >> 1, wn = wv & 1, l31 = lane & 31, h = lane >> 5;
  bfr* sA = (bfr*)smem; bfr* sB = sA + 128 * 72;
  const bfr* Y = (const bfr*)(WS_ + O_Y);
  float* X = (float*)(WS_ + O_X);
  for (int it = 0;; ++it) {
    int mt, nt;
    if (!tile_order(it, 136, 16, 34, 4, mt, nt)) break;
    if (mt < 0) continue;
    const int m0 = mt * 128, n0 = nt * 128;
    if (l == 3 && (m0 % SP) < CTX) continue;
    f32x16 acc[2][2];
    for (int i = 0; i < 2; ++i) for (int j = 0; j < 2; ++j) acc[i][j] = zero16();
    gemm_main<2>(Y + (size_t)m0 * DM, DM, (const bfr*)(WS_ + O_WOUT) + ((size_t)l * 2048 + n0) * 2048, 2048, 2048, acc, sA, sB);
    const float* M = (const float*)(WS_ + O_MODS) + ((size_t)l * 5 + mod_vec(m0)) * 6144 + 4096;
#pragma unroll
    for (int mi = 0; mi < 2; ++mi)
#pragma unroll
      for (int ni = 0; ni < 2; ++ni) {
        const int col = n0 + wn * 64 + ni * 32 + l31, rb = m0 + wm * 64 + mi * 32;
        const float gt = M[col];
#pragma unroll
        for (int r = 0; r < 16; ++r) { float* d = X + (size_t)(rb + crow(r, h)) * DM + col; *d = *d + gt * acc[mi][ni][r]; }
      }
  }
}

DI void phase_final(const Params& p) {
  unsigned char* const WS_ = launder_ptr(p.ws);
  const int tid_ = opaque_tid(), lane = tid_ & 63, gw = blockIdx.x * 4 + (tid_ >> 6), nw = gridDim.x * 4;
  const float* X = (const float*)(WS_ + O_X);
  for (int r = gw; r < NB * SEQ; r += nw) {
    const int b = r >> 12, t = r & 4095;
    const f32x4* xr = (const f32x4*)(X + ((size_t)b * SP + CTX + t) * DM);
    f32x4 v[8]; float ss = 0.f;
#pragma unroll
    for (int j = 0; j < 8; ++j) { v[j] = xr[lane + 64 * j]; ss += v[j][0] * v[j][0] + v[j][1] * v[j][1] + v[j][2] * v[j][2] + v[j][3] * v[j][3]; }
#pragma unroll
    for (int o = 1; o < 64; o <<= 1) ss += __shfl_xor(ss, o);
    const float rs = rsqrtf(ss * (1.f / DM) + EPS);
    f32x4* dst = (f32x4*)(p.out + (size_t)r * DM);
#pragma unroll
    for (int j = 0; j < 8; ++j) {
      const f32x4 g = *(const f32x4*)(p.final_g + 4 * (lane + 64 * j));
      f32x4 o; for (int q = 0; q < 4; ++q) o[q] = v[j][q] * rs * g[q];
      dst[lane + 64 * j] = o;
    }
  }
}

DI void gbar(unsigned char* ws, unsigned& epoch) {
  __syncthreads();
  if (threadIdx.x == 0) {
    unsigned* bar = (unsigned*)(ws + O_BAR);
    epoch += 1;
    __builtin_amdgcn_fence(__ATOMIC_RELEASE, "agent");
    asm volatile("s_waitcnt vmcnt(0)" ::: "memory");
    const unsigned g = blockIdx.x & 7, ng = (gridDim.x + 7 - g) >> 3;
    const unsigned prev = __hip_atomic_fetch_add(bar + 64 * g, 1u, __ATOMIC_RELAXED, __HIP_MEMORY_SCOPE_AGENT);
    if (prev + 1 == ng * epoch) {
      const unsigned pt = __hip_atomic_fetch_add(bar + 64 * 16, 1u, __ATOMIC_RELAXED, __HIP_MEMORY_SCOPE_AGENT);
      if (pt + 1 == 8 * epoch) {
        for (int j = 0; j < 8; ++j) __hip_atomic_store(bar + 64 * (8 + j), epoch, __ATOMIC_RELAXED, __HIP_MEMORY_SCOPE_AGENT);
      }
    }
    while (__hip_atomic_load(bar + 64 * (8 + g), __ATOMIC_RELAXED, __HIP_MEMORY_SCOPE_AGENT) < epoch) __builtin_amdgcn_s_sleep(1);
    __builtin_amdgcn_fence(__ATOMIC_ACQUIRE, "agent");
    asm volatile("s_waitcnt vmcnt(0)" ::: "memory");
  }
  __syncthreads();
}

__global__ void __launch_bounds__(256, 2) mega(Params p) {
  cg::grid_group grid = cg::this_grid();
  __shared__ __attribute__((aligned(16))) unsigned char smem[SMEM_BYTES];
  __shared__ int s_item;
  phase0(p, smem);
  grid.sync();
  unsigned epoch = 0;
#pragma unroll 1
  for (int l = 0; l < 4; ++l) {
    phase_adaln(p, l, smem);
    gbar(p.ws, epoch);
    phase_inproj(p, l, smem);
    gbar(p.ws, epoch);
    {
      constexpr int N_DFT = 544, N_DN = DN_UNITS, N_HG = HG_UNITS;
      const int tid = opaque_tid();
      unsigned* ctr3 = (unsigned*)(p.ws + O_CTR) + 8 + l;
      const int n_att3 = (l < 3) ? 96 : 64;
      if (gridDim.x == 512) {
        const int xcd = blockIdx.x & 7, local = blockIdx.x >> 3;
        const int mt = (xcd & 3) * 8 + (local >> 3), nn = (xcd >> 2) * 8 + (local & 7);
        dft_tile(p, (nn >> 2) * 128 + mt * 4 + (nn & 3), smem);
      }
      const int dft0 = (gridDim.x == 512) ? 512 : 0;
      for (;;) {
        __syncthreads();
        if (tid == 0) s_item = (int)atomicAdd(ctr3, 1u);
        __syncthreads();
        const int it = s_item - n_att3 + dft0;
        if (it >= N_DFT + N_DN + N_HG) break;
        if (it < dft0) attn_unit(p, l, 448 + (it - dft0) + n_att3, smem);
        else if (it < N_DFT) { if (l < 3 || it < 512) dft_tile(p, it, smem); }
        else if (it < N_DFT + N_DN) dn_prep_unit(p, l, it - N_DFT, smem);
        else hg_prep_unit(p, l, it - N_DFT - N_DN, smem);
      }
    }
    gbar(p.ws, epoch);
    {
      const int tid = opaque_tid();
      if (blockIdx.x < 32) dn_scan_block(p, 0, smem);
      else if (blockIdx.x < 64) hg_scan_block(p, 32, smem);
      unsigned* ctr = (unsigned*)(p.ws + O_CTR) + l;
      const int n_attn = 448;
      for (;;) {
        __syncthreads();
        if (tid == 0) s_item = (int)atomicAdd(ctr, 1u);
        __syncthreads();
        const int item = s_item;
        if (item >= n_attn + 544) break;
        if (item < n_attn) attn_unit(p, l, item, smem);
        else { const int ft = item - n_attn; if (!(l == 3 && (((ft >> 2) * 128) % SP) < CTX)) fnw_tile(p, l, ft, smem); }
      }
    }
    gbar(p.ws, epoch);
    phase_finalize(p, l);
    gbar(p.ws, epoch);
    phase_merge(p, l, smem);
    gbar(p.ws, epoch);
    phase_out(p, l, smem);
    gbar(p.ws, epoch);
  }
  phase_final(p);
}

extern "C" void kernel_launch(void* const* d_in, const int* in_sizes, int n_in, void* d_out, int out_size, void* d_ws, size_t ws_size,
                              hipStream_t stream) {
  static int grid_blocks = 0;
  if (!grid_blocks) {
    int dev = 0, cus = 0, per_cu = 0;
    hipGetDevice(&dev);
    hipDeviceGetAttribute(&cus, hipDeviceAttributeMultiprocessorCount, dev);
    hipOccupancyMaxActiveBlocksPerMultiprocessor(&per_cu, (const void*)mega, 256, 0);
    if (per_cu < 1) per_cu = 1;
    if (per_cu > 2) per_cu = 2;
    grid_blocks = cus * per_cu;
    if (ws_size < O_END) fprintf(stderr, "workspace too small: %zu < %zu\n", ws_size, (size_t)O_END);
  }
  Params p{};
  const float** f = (const float**)&p;
  for (int i = 0; i < 21; ++i) f[i] = (const float*)d_in[i];
  p.out = (float*)d_out;
  p.ws = (unsigned char*)d_ws;
  void* args[] = {&p};
  hipError_t e = hipLaunchCooperativeKernel((const void*)mega, dim3(grid_blocks), dim3(256), args, 0, stream);
  if (e != hipSuccess) fprintf(stderr, "cooperative launch failed: %s (grid %d)\n", hipGetErrorString(e), grid_blocks);
}
```

```cpp
#include <hip/hip_runtime.h>
#include <hip/hip_cooperative_groups.h>
#include <cstdio>
namespace cg = cooperative_groups;

#define DI __device__ __forceinline__
typedef unsigned short bfr;
using bf16x8 = __attribute__((ext_vector_type(8))) short;
using s16x4  = __attribute__((ext_vector_type(4))) short;
using f32x16 = __attribute__((ext_vector_type(16))) float;
using f32x4  = __attribute__((ext_vector_type(4))) float;
using u32x4  = __attribute__((ext_vector_type(4))) unsigned;
using u32x2  = __attribute__((ext_vector_type(2))) unsigned;
typedef __bf16 bf2_t __attribute__((ext_vector_type(2)));
typedef float f2_t __attribute__((ext_vector_type(2)));
#define MFMA(a, b, c) __builtin_amdgcn_mfma_f32_32x32x16_bf16((a), (b), (c), 0, 0, 0)

constexpr int NB = 4, SEQ = 4096, CTX = 256, SP = 4352, NTOK = 17408, DM = 2048;
constexpr int PLD = 16384, NWIN = 16384, INW = 15888;
constexpr int C_FNZ = 1024, C_DNQ = 1536, C_DNK = 2048, C_DNV = 2560, C_DNZ = 3072, C_HGQ = 3584, C_HGF = 4096,
              C_HGI = 5120, C_HGZ = 5632, C_DAQ = 6144, C_DAK = 6656, C_DAV = 7168, C_DAZ = 7680, C_GATE = 8192;
constexpr float EPS = 1e-6f;
constexpr int DN_UNITS = 2 * 4 * 4 * 68, DN_USZ = 36864;
constexpr int HG_UNITS = 2 * 4 * 4 * 136, HG_USZ = 12288;

constexpr size_t al(size_t x) { return (x + 255) & ~(size_t)255; }
constexpr size_t O_X = 0;
constexpr size_t O_H = O_X + al((size_t)NTOK * DM * 4);
constexpr size_t O_P = O_H + al((size_t)NTOK * DM * 2);
constexpr size_t O_AB = O_P + al((size_t)NTOK * PLD * 2);
constexpr size_t O_FTL = O_AB + al((size_t)NTOK * 16 * 4);
constexpr size_t O_FTC = O_FTL + al((size_t)4 * 512 * 8192 * 2);
constexpr size_t O_VT = O_FTC + al((size_t)4 * 512 * 512 * 2);
constexpr size_t O_F = O_VT + al((size_t)NTOK * 512 * 2);
constexpr size_t O_YS = O_F + al((size_t)NTOK * 512 * 2);
constexpr size_t O_Y = O_YS + al((size_t)NTOK * DM * 2);
constexpr size_t O_WIN = O_Y + al((size_t)NTOK * DM * 2);
constexpr size_t O_WBR = O_WIN + al((size_t)4 * NWIN * DM * 2);
constexpr size_t O_WOUT = O_WBR + al((size_t)16 * 2048 * 512 * 2);
constexpr size_t O_FNW = O_WOUT + al((size_t)4 * 2048 * 2048 * 2);
constexpr size_t O_DFTL = O_FNW + al((size_t)4 * 512 * 512 * 2);
constexpr size_t O_DFTC = O_DFTL + al((size_t)4096 * 8192 * 2);
constexpr size_t O_ROPE = O_DFTC + al((size_t)256 * 512 * 2);
constexpr size_t O_MODS = O_ROPE + al((size_t)4096 * 32 * 2 * 4);
constexpr size_t O_LB = O_MODS + al((size_t)4 * 5 * 6144 * 4);
constexpr size_t O_LAM = O_LB + al((size_t)4 * 2 * 512 * 4);
constexpr size_t O_CTR = O_LAM + 256;
constexpr size_t O_BAR = O_CTR + 256;
constexpr size_t O_DNU = O_BAR + 64 * 17 * 4 + 256;
constexpr size_t O_DNG = O_DNU + al((size_t)DN_UNITS * DN_USZ * 2);
constexpr size_t O_ODN = O_DNG + al((size_t)DN_UNITS * 4);
constexpr size_t O_HGU = O_ODN + al((size_t)2 * NTOK * 512 * 4);
constexpr size_t O_HGD = O_HGU + al((size_t)HG_UNITS * HG_USZ * 2);
constexpr size_t O_OHG = O_HGD + al((size_t)HG_UNITS * 128 * 4);
constexpr size_t O_END = O_OHG + al((size_t)2 * NTOK * 512 * 4);

struct Params {
  const float *x, *c, *ctx, *c_ctx, *norm_g, *w_ada, *b_ada, *w_in, *fn_w, *fn_b, *dn_conv, *dn_a_log, *dn_dt_bias,
      *dn_norm, *hg_lb_logits, *hg_norm, *da_lambda, *da_norm, *w_branch, *w_out, *final_g;
  float* out;
  unsigned char* ws;
};

constexpr int SMEM_BYTES = 73728;

DI float bf2f(bfr v) { return __uint_as_float(((unsigned)v) << 16); }
DI unsigned pk2(float a, float b) { f2_t v = {a, b}; bf2_t r = __builtin_convertvector(v, bf2_t); return __builtin_bit_cast(unsigned, r); }
DI bfr f2bf(float a) { return (bfr)(pk2(a, 0.f) & 0xffffu); }
DI float sigmoidf_(float x) { return 1.f / (1.f + __expf(-x)); }
DI float siluf_(float x) { return x / (1.f + __expf(-x)); }
DI int crow(int r, int h) { return (r & 3) + 8 * (r >> 2) + 4 * h; }
template <int S> DI bf16x8 pack8(const f32x16& x) {
  u32x4 p;
  p[0] = pk2(x[8 * S + 0], x[8 * S + 1]); p[1] = pk2(x[8 * S + 2], x[8 * S + 3]);
  p[2] = pk2(x[8 * S + 4], x[8 * S + 5]); p[3] = pk2(x[8 * S + 6], x[8 * S + 7]);
  return __builtin_bit_cast(bf16x8, p);
}
DI bf16x8 ld16(const bfr* p) { return *(const bf16x8*)p; }
DI bf16x8 ld2x8(const bfr* p) {
  s16x4 lo = *(const s16x4*)p, hi = *(const s16x4*)(p + 8);
  return __builtin_shufflevector(lo, hi, 0, 1, 2, 3, 4, 5, 6, 7);
}
DI unsigned char* launder_ptr(unsigned char* q) { asm volatile("" : "+s"(q)); return q; }
DI int opaque_tid() { int t = threadIdx.x; asm volatile("" : "+v"(t)); return t; }
DI int fragp_idx(int row, int col, int KB) {
  const int rb = row >> 5, l31 = row & 31, kb = col >> 5, c = col & 31;
  const int s = c >> 4, jhi = (c >> 3) & 1, h = (c >> 2) & 1, jlo = c & 3;
  return ((((rb * KB + kb) * 2 + s) * 64 + h * 32 + l31) << 3) + jhi * 4 + jlo;
}
DI int fragn_idx(int row, int col, int KS) {
  const int rb = row >> 5, l31 = row & 31, s = col >> 4, h = (col >> 3) & 1, j = col & 7;
  return (((rb * KS + s) * 64 + h * 32 + l31) << 3) + j;
}
DI f32x16 zero16() { f32x16 z; for (int i = 0; i < 16; ++i) z[i] = 0.f; return z; }
DI int mod_vec(int row) { int b = row / SP, s = row - b * SP; return s < CTX ? 4 : b; }

template <int ROWS>
DI void stage_tile(const bfr* __restrict__ G, int ld, unsigned char* lds, int tid) {
#pragma unroll
  for (int i = 0; i < ROWS / 32; ++i) {
    const int ci = i * 256 + tid, line = ci >> 4, slot = ci & 15, v = slot ^ (line & 15), r = line * 2 + (v >> 3), c16 = v & 7;
    __builtin_amdgcn_global_load_lds((const __attribute__((address_space(1))) void*)(G + (size_t)r * ld + c16 * 8),
                                     (__attribute__((address_space(3))) void*)(lds + ci * 16), 16, 0, 0);
  }
}
template <int NI>
DI void gemm_main(const bfr* __restrict__ A, int lda, const bfr* __restrict__ Bt, int ldb, int K, f32x16 (&acc)[2][NI], bfr* sA_, bfr* sB_) {
  const int tid = opaque_tid(), lane = tid & 63, wv = tid >> 6, wm = wv >> 1, wn = wv & 1, l31 = lane & 31, h = lane >> 5;
  unsigned char* const base = (unsigned char*)sA_;
  constexpr int BUFSZ = 16384 + 8192 * NI;
  const int lane_off = (l31 >> 1) * 256, y = (((l31 & 1) << 3) ^ (l31 >> 1) ^ h);
  const int nk = K >> 6;
  __syncthreads();
  stage_tile<128>(A, lda, base, tid);
  stage_tile<64 * NI>(Bt, ldb, base + 16384, tid);
  for (int kt = 0; kt < nk; ++kt) {
    asm volatile("s_waitcnt vmcnt(0)" ::: "memory");
    __builtin_amdgcn_s_barrier();
    const unsigned char* cur = base + (kt & 1) * BUFSZ;
    bf16x8 af[4][2], bq[4][NI];
#pragma unroll
    for (int ks = 0; ks < 4; ++ks) {
      const int so = ((y ^ (2 * ks)) << 4) + lane_off;
#pragma unroll
      for (int i = 0; i < 2; ++i) af[ks][i] = *(const bf16x8*)(cur + (wm * 32 + i * 16) * 256 + so);
#pragma unroll
      for (int i = 0; i < NI; ++i) bq[ks][i] = *(const bf16x8*)(cur + 16384 + (wn * 16 * NI + i * 16) * 256 + so);
    }
    __builtin_amdgcn_sched_barrier(0);
    if (kt + 1 < nk) {
      unsigned char* nxt = base + ((kt + 1) & 1) * BUFSZ;
      stage_tile<128>(A + (kt + 1) * 64, lda, nxt, tid);
      stage_tile<64 * NI>(Bt + (kt + 1) * 64, ldb, nxt + 16384, tid);
    }
    __builtin_amdgcn_sched_barrier(0);
#pragma unroll
    for (int ks = 0; ks < 4; ++ks)
#pragma unroll
      for (int mi = 0; mi < 2; ++mi)
#pragma unroll
        for (int ni = 0; ni < NI; ++ni) acc[mi][ni] = MFMA(af[ks][mi], bq[ks][ni], acc[mi][ni]);
  }
}

template <int ROWS>
DI void stage_tile32(const bfr* __restrict__ G, unsigned char* lds, int tid) {
#pragma unroll
  for (int i = 0; i < ROWS / 64; ++i) {
    const int ci = i * 256 + tid, line = ci >> 4, slot = ci & 15, r = line * 4 + (slot >> 2), c16 = (slot & 3) ^ (line & 3);
    __builtin_amdgcn_global_load_lds((const __attribute__((address_space(1))) void*)(G + r * 32 + c16 * 8),
                                     (__attribute__((address_space(3))) void*)(lds + ci * 16), 16, 0, 0);
  }
}
DI bf16x8 lds_read16_asm(unsigned addr) {
  bf16x8 r;
  asm volatile("ds_read_b128 %0, %1" : "=v"(r) : "v"(addr));
  return r;
}
DI void gemm_big(const bfr* __restrict__ A, size_t sa, const bfr* __restrict__ Bt, size_t sb, int K, f32x16 (&acc)[2][4], unsigned char* base) {
  const int tid = opaque_tid(), lane = tid & 63, wv = tid >> 6, wm = wv >> 1, wn = wv & 1, l31 = lane & 31, h = lane >> 5;
  constexpr int BUFSZ = 8192 + 16384;
  const int lane_off = (l31 >> 2) * 256 + (l31 & 3) * 64, x = (l31 >> 2) & 3;
  const int nk = K >> 5;
  const unsigned lbase = (unsigned)(size_t)base;
  __syncthreads();
  stage_tile32<128>(A, base, tid);
  stage_tile32<256>(Bt, base + 8192, tid);
  stage_tile32<128>(A + sa, base + BUFSZ, tid);
  stage_tile32<256>(Bt + sb, base + BUFSZ + 8192, tid);
  int bc = 0;
  for (int kt = 0; kt < nk; ++kt) {
    if (kt + 1 < nk) asm volatile("s_waitcnt vmcnt(6)" ::: "memory");
    else asm volatile("s_waitcnt vmcnt(0)" ::: "memory");
    __builtin_amdgcn_s_barrier();
    const unsigned cur = lbase + bc * BUFSZ;
    bf16x8 af[2][2], bq[2][4];
#pragma unroll
    for (int ks = 0; ks < 2; ++ks) {
      const unsigned so = cur + lane_off + ((((ks * 2) | h) ^ x) << 4);
#pragma unroll
      for (int i = 0; i < 2; ++i) af[ks][i] = lds_read16_asm(so + (wm * 16 + i * 8) * 256);
#pragma unroll
      for (int i = 0; i < 4; ++i) bq[ks][i] = lds_read16_asm(so + 8192 + (wn * 32 + i * 8) * 256);
    }
    if (kt + 2 < nk) {
      const int bn = bc >= 1 ? bc - 1 : 2;
      unsigned char* nxt = base + bn * BUFSZ;
      stage_tile32<128>(A + (size_t)(kt + 2) * sa, nxt, tid);
      stage_tile32<256>(Bt + (size_t)(kt + 2) * sb, nxt + 8192, tid);
    }
    asm volatile("s_waitcnt lgkmcnt(0)"
                 : "+v"(af[0][0]), "+v"(af[0][1]), "+v"(af[1][0]), "+v"(af[1][1]), "+v"(bq[0][0]), "+v"(bq[0][1]), "+v"(bq[0][2]), "+v"(bq[0][3]),
                   "+v"(bq[1][0]), "+v"(bq[1][1]), "+v"(bq[1][2]), "+v"(bq[1][3])
                 :: "memory");
#pragma unroll
    for (int ks = 0; ks < 2; ++ks)
#pragma unroll
      for (int mi = 0; mi < 2; ++mi)
#pragma unroll
        for (int ni = 0; ni < 4; ++ni) acc[mi][ni] = MFMA(af[ks][mi], bq[ks][ni], acc[mi][ni]);
    bc = bc == 2 ? 0 : bc + 1;
  }
}

DI bool tile_order(int it, int nM, int nN, int SM, int SN, int& mt, int& nt) {
  const int G = gridDim.x, xcd = blockIdx.x & 7, local = blockIdx.x >> 3, per = G >> 3;
  const int sN = nN / SN, nsup = (nM / SM) * sN, ST = SM * SN;
  const long j = (long)it * per + local;
  const int sup = xcd + 8 * (int)(j / ST), within = (int)(j % ST);
  if (sup >= nsup) { mt = -1; return false; }
  const int sm = sup / sN, sn = sup % sN;
  mt = sm * SM + within / SN; nt = sn * SN + within % SN;
  return true;
}

DI bool tile_order_mfast(int it, int nM, int nN, int SM, int SN, int& mt, int& nt) {
  const int G = gridDim.x, xcd = blockIdx.x & 7, local = blockIdx.x >> 3, per = G >> 3;
  const int sM = nM / SM, nsup = sM * (nN / SN), ST = SM * SN;
  const long j = (long)it * per + local;
  const int sup = xcd + 8 * (int)(j / ST), within = (int)(j % ST);
  if (sup >= nsup) { mt = -1; return false; }
  const int sm = sup % sM, sn = sup / sM;
  mt = sm * SM + within / SN; nt = sn * SN + within % SN;
  return true;
}

DI int win_srccol(int n) { return n < 3584 ? n - 512 : n - 496; }

DI void tr_tile(const float* __restrict__ src, int ldsrc, int k0, int n0, bool winmap, bfr* __restrict__ dst, int lddst, float* sT, int slab_rows = 0) {
  const int tid = opaque_tid();
  __syncthreads();
  {
    const int nn = tid & 63;
    const int sc = winmap ? win_srccol(n0 + nn) : (n0 + nn);
    float tv[64];
#pragma unroll
    for (int i = 0; i < 64; ++i) {
      const int kk = (tid >> 6) + 4 * i;
      tv[i] = sc >= 0 ? src[(size_t)(k0 + kk) * ldsrc + sc] : 0.f;
    }
#pragma unroll
    for (int i = 0; i < 64; ++i) sT[((tid >> 6) + 4 * i) * 65 + nn] = tv[i];
  }
  __syncthreads();
#pragma unroll
  for (int i = 0; i < 8; ++i) {
    const int e = tid + 256 * i, w = e >> 6, lane = e & 63;
    const int nn = (w >> 2) * 8 + (lane >> 3), kc = (w & 3) * 8 + (lane & 7);
    const float* s = sT + (8 * kc) * 65 + nn;
    u32x4 o;
    o[0] = pk2(s[0], s[65]); o[1] = pk2(s[130], s[195]); o[2] = pk2(s[260], s[325]); o[3] = pk2(s[390], s[455]);
    const int k = k0 + 8 * kc;
    if (slab_rows) *(u32x4*)(dst + ((size_t)(k >> 5) * slab_rows + (n0 + nn)) * 32 + (k & 31)) = o;
    else *(u32x4*)(dst + (size_t)(n0 + nn) * lddst + k) = o;
  }
}

DI void phase0(const Params& p, unsigned char* smem) {
  unsigned char* const WS_ = launder_ptr(p.ws);
  const int tid = opaque_tid(), lane = tid & 63, wv = tid >> 6;
  float* sF = (float*)smem;
  bfr* WIN = (bfr*)(WS_ + O_WIN); bfr* WBR = (bfr*)(WS_ + O_WBR); bfr* WOUT = (bfr*)(WS_ + O_WOUT); bfr* FNW = (bfr*)(WS_ + O_FNW);
  constexpr int I_MODS = 384, I_WIN = 4 * 240 * 8, I_WBR = 16 * 32 * 2, I_WOUT = 4 * 32 * 8, I_FNW = 4 * 8 * 2, I_FOLD = 512,
                I_DFTL = 4096, I_DFTC = 256, I_ROPE = 512, I_X = NTOK / 8, I_MISC = 1;
  constexpr int B1 = I_MODS, B2 = B1 + I_WIN, B3 = B2 + I_WBR, B4 = B3 + I_WOUT, B5 = B4 + I_FNW, B6 = B5 + I_FOLD, B7 = B6 + I_DFTL,
                B8 = B7 + I_DFTC, B9 = B8 + I_ROPE, B10 = B9 + I_X, B11 = B10 + I_MISC;
  for (int it = blockIdx.x; it < B11; it += gridDim.x) {
    if (it < B1) {
      __syncthreads();
      for (int e = tid; e < 5 * 2048; e += 256) { const float cv = e < 4 * 2048 ? p.c[e] : p.c_ctx[e - 4 * 2048]; sF[e] = siluf_(cv); }
      __syncthreads();
      const int l = it / 96, j = (it % 96) * 64 + lane, kq = wv;
      const float* w = p.w_ada + (size_t)l * 2048 * 6144 + j;
      float a0 = 0.f, a1 = 0.f, a2 = 0.f, a3 = 0.f, a4 = 0.f;
#pragma unroll 32
      for (int k = kq * 512; k < kq * 512 + 512; ++k) {
        const float wv_ = w[(size_t)k * 6144];
        a0 += sF[k] * wv_; a1 += sF[2048 + k] * wv_; a2 += sF[4096 + k] * wv_; a3 += sF[6144 + k] * wv_; a4 += sF[8192 + k] * wv_;
      }
      float* red = sF + 10240 + (kq * 5) * 64 + lane;
      red[0] = a0; red[64] = a1; red[128] = a2; red[192] = a3; red[256] = a4;
      __syncthreads();
      if (wv == 0) {
        const float bb = p.b_ada[l * 6144 + j];
        float* M = (float*)(WS_ + O_MODS) + (size_t)l * 5 * 6144 + j;
        for (int v = 0; v < 5; ++v) {
          const float* r = sF + 10240 + v * 64 + lane;
          M[(size_t)v * 6144] = r[0] + r[320] + r[640] + r[960] + bb;
        }
      }
    } else if (it < B2) {
      const int r = it - B1, l = r / (240 * 8), q = r % (240 * 8), ntile = q / 8, kt = q % 8;
      tr_tile(p.w_in + (size_t)l * 2048 * INW, INW, kt * 256, 1024 + ntile * 64, true, WIN + (size_t)l * NWIN * DM, DM, sF, NWIN);
    } else if (it < B3) {
      const int r = it - B2, mtx = r / 64, q = r % 64, ntile = q / 2, kt = q % 2;
      tr_tile(p.w_branch + (size_t)mtx * 512 * 2048, 2048, kt * 256, ntile * 64, false, WBR + (size_t)mtx * 2048 * 512, 512, sF);
    } else if (it < B4) {
      const int r = it - B3, l = r / 256, q = r % 256, ntile = q / 8, kt = q % 8;
      tr_tile(p.w_out + (size_t)l * 2048 * 2048, 2048, kt * 256, ntile * 64, false, WOUT + (size_t)l * 2048 * 2048, 2048, sF);
    } else if (it < B5) {
      const int r = it - B4, l = r / 16, q = r % 16, ntile = q / 2, kt = q % 2;
      tr_tile(p.fn_w + (size_t)l * 512 * 512, 512, kt * 256, ntile * 64, false, FNW + (size_t)l * 512 * 512, 512, sF);
    } else if (it < B6) {
      const int r = it - B5, l = r / 128, g = (r / 32) & 3, kt = r & 31, k0 = kt * 64;
      float* sW = sF;
      float* tc = sF + 64 * 129;
      __syncthreads();
      for (int e = tid; e < 64 * 128; e += 256) { const int kk = e >> 7, cc = e & 127; sW[kk * 129 + cc] = p.w_in[((size_t)l * 2048 + k0 + kk) * INW + g * 128 + cc]; }
      if (tid < 128) { tc[tid] = cospif((float)tid / 64.f) * 0.08838834764831845f; tc[128 + tid] = sinpif((float)tid / 64.f) * 0.08838834764831845f; }
      __syncthreads();
      {
        const int l31f = lane & 31, hf = lane >> 5;
#pragma unroll 1
        for (int cb2 = 0; cb2 < 2; ++cb2) {
          const int cb = wv * 2 + cb2;
          const int colg = cb * 32 + l31f, part = colg >> 7, cp = colg & 127;
          const float* tb = tc + part * 128;
          f32x16 o0 = zero16(), o1 = zero16();
#pragma unroll 8
          for (int s = 0; s < 64; ++s) {
            const int cc = 2 * s + hf;
            const float bv = tb[(cc * cp) & 127];
            o0 = __builtin_amdgcn_mfma_f32_32x32x2f32(sW[l31f * 129 + cc], bv, o0, 0, 0, 0);
            o1 = __builtin_amdgcn_mfma_f32_32x32x2f32(sW[(32 + l31f) * 129 + cc], bv, o1, 0, 0, 0);
          }
          bfr* dstn = WIN + (size_t)l * NWIN * DM + (size_t)(part * 512 + g * 128 + cp) * 32;
#pragma unroll
          for (int rb2 = 0; rb2 < 2; ++rb2) {
            const f32x16& oo = rb2 ? o1 : o0;
#pragma unroll
            for (int gq = 0; gq < 4; ++gq) {
              const int kr = k0 + rb2 * 32 + 8 * gq + 4 * hf;
              u32x2 w; w[0] = pk2(oo[4 * gq], oo[4 * gq + 1]); w[1] = pk2(oo[4 * gq + 2], oo[4 * gq + 3]);
              *(u32x2*)(dstn + (size_t)(kr >> 5) * NWIN * 32 + (kr & 31)) = w;
            }
          }
        }
      }
    } else if (it < B7) {
      const int f = it - B6;
      unsigned* dst = (unsigned*)(WS_ + O_DFTL) + (size_t)f * 4096;
      for (int e = tid; e < 4096; e += 256) {
        float v[2];
        for (int q = 0; q < 2; ++q) {
          const int kk = 2 * e + q, k = kk & 4095, m = (f * k) & 4095;
          v[q] = (kk >> 12) ? -sinpif((float)m / 2048.f) * 0.015625f : cospif((float)m / 2048.f) * 0.015625f;
        }
        dst[e] = pk2(v[0], v[1]);
      }
    } else if (it < B8) {
      const int f = it - B7;
      unsigned* dst = (unsigned*)(WS_ + O_DFTC) + (size_t)f * 256;
      {
        const int e = tid;
        float v[2];
        for (int q = 0; q < 2; ++q) {
          const int kk = 2 * e + q, k = kk & 255, m = (f * k) & 255;
          v[q] = (kk >> 8) ? -sinpif((float)m / 128.f) * 0.0625f : cospif((float)m / 128.f) * 0.0625f;
        }
        dst[e] = pk2(v[0], v[1]);
      }
    } else if (it < B9) {
      const int e = (it - B8) * 256 + tid, pos = e >> 5, a = e & 31;
      const float inv = powf(10000.f, -(float)(a & 15) / 16.f);
      const float ang = (a < 16 ? (float)(pos >> 6) : (float)(pos & 63)) * inv;
      float* R = (float*)(WS_ + O_ROPE) + (size_t)e * 2;
      R[0] = cosf(ang); R[1] = sinf(ang);
    } else if (it < B10) {
      const int r0 = (it - B9) * 8;
      f32x4* X = (f32x4*)(WS_ + O_X);
      for (int e = tid; e < 8 * 512; e += 256) {
        const int row = r0 + (e >> 9), cc = e & 511, b = row / SP, s = row - b * SP;
        const f32x4* src = s < CTX ? (const f32x4*)(p.ctx + ((size_t)b * CTX + s) * DM) : (const f32x4*)(p.x + ((size_t)b * SEQ + s - CTX) * DM);
        X[(size_t)row * 512 + cc] = src[cc];
      }
    } else {
      for (int e = tid; e < 1024; e += 256) {
        const int d = e >> 9, cc = e & 511;
        float lg[4], mx = -1e30f;
        for (int l = 0; l < 4; ++l) { lg[l] = p.hg_lb_logits[(d * 4 + l) * 512 + cc]; mx = fmaxf(mx, lg[l]); }
        float sum = 0.f;
        for (int l = 0; l < 4; ++l) { lg[l] = expf(lg[l] - mx); sum += lg[l]; }
        float cum = 0.f;
        float* LBp = (float*)(WS_ + O_LB);
        for (int l = 0; l < 4; ++l) { if (l > 0) cum += lg[l] / sum; LBp[(l * 2 + d) * 512 + cc] = cum; }
      }
      if (tid < 4) {
        const float* lp = p.da_lambda + tid * 256;
        float s1 = 0.f, s2 = 0.f;
        for (int d = 0; d < 64; ++d) { s1 += lp[d] * lp[64 + d]; s2 += lp[128 + d] * lp[192 + d]; }
        const float lam_init = 0.8f - 0.6f * expf(-0.3f * (float)tid);
        ((float*)(WS_ + O_LAM))[tid] = expf(s1) - expf(s2) + lam_init;
      }
      if (tid < 16) ((unsigned*)(WS_ + O_CTR))[tid] = 0u;
      for (int e = tid; e < 64 * 17; e += 256) ((unsigned*)(WS_ + O_BAR))[e] = 0u;
    }
  }
}

DI void phase_adaln(const Params& p, int l, unsigned char* smem) {
  unsigned char* const WS_ = launder_ptr(p.ws);
  const int tid_ = opaque_tid(), lane = tid_ & 63, gw = blockIdx.x * 4 + (tid_ >> 6), nw = gridDim.x * 4;
  const float* X = (const float*)(WS_ + O_X);
  bfr* H = (bfr*)(WS_ + O_H);
  float* AB = (float*)(WS_ + O_AB);
  const float* ng = p.norm_g + l * DM;
  bfr* sW = (bfr*)smem;
  __syncthreads();
  {
    const float* wsrc = p.w_in + (size_t)l * 2048 * INW + 3072;
    f32x4 t[32];
#pragma unroll
    for (int i = 0; i < 32; ++i) { const int e = tid_ + 256 * i, k = e >> 2, c4 = e & 3; t[i] = *(const f32x4*)(wsrc + (size_t)k * INW + 4 * c4); }
#pragma unroll
    for (int i = 0; i < 32; ++i) {
      const int e = tid_ + 256 * i, k = e >> 2, c4 = e & 3;
      u32x2 w; w[0] = pk2(t[i][0], t[i][1]); w[1] = pk2(t[i][2], t[i][3]);
      const int pos = ((k >> 8) * 4 + (k & 3)) * 64 + ((k >> 2) & 63);
      *(u32x2*)(sW + (c4 >> 1) * 16384 + pos * 8 + (c4 & 1) * 4) = w;
    }
  }
  __syncthreads();
  for (int row = gw; row < NTOK; row += nw) {
    const float* M = (const float*)(WS_ + O_MODS) + ((size_t)l * 5 + mod_vec(row)) * 6144;
    const f32x4* xr = (const f32x4*)(X + (size_t)row * DM);
    f32x4 v[8]; float ss = 0.f;
#pragma unroll
    for (int j = 0; j < 8; ++j) { v[j] = xr[lane + 64 * j]; ss += v[j][0] * v[j][0] + v[j][1] * v[j][1] + v[j][2] * v[j][2] + v[j][3] * v[j][3]; }
#pragma unroll
    for (int o = 1; o < 64; o <<= 1) ss += __shfl_xor(ss, o);
    const float rs = rsqrtf(ss * (1.f / DM) + EPS);
    float ab[16];
#pragma unroll
    for (int c = 0; c < 16; ++c) ab[c] = 0.f;
#pragma unroll
    for (int j = 0; j < 8; ++j) {
      const int c0 = 4 * (lane + 64 * j);
      const f32x4 g = *(const f32x4*)(ng + c0), sh = *(const f32x4*)(M + c0), sc = *(const f32x4*)(M + 2048 + c0);
      float o[4];
      for (int q = 0; q < 4; ++q) o[q] = v[j][q] * rs * g[q] * (1.f + sc[q]) + sh[q];
      u32x2 w; w[0] = pk2(o[0], o[1]); w[1] = pk2(o[2], o[3]);
      *(u32x2*)(H + ((size_t)(c0 >> 5) * NTOK + row) * 32 + (c0 & 31)) = w;
#pragma unroll
      for (int q = 0; q < 4; ++q) {
        const bf16x8 w0 = ld16(sW + ((j * 4 + q) * 64 + lane) * 8), w1 = ld16(sW + 16384 + ((j * 4 + q) * 64 + lane) * 8);
#pragma unroll
        for (int c = 0; c < 8; ++c) { ab[c] += o[q] * bf2f((bfr)w0[c]); ab[8 + c] += o[q] * bf2f((bfr)w1[c]); }
      }
    }
#pragma unroll
    for (int c = 0; c < 16; ++c) {
      float s = ab[c];
#pragma unroll
      for (int o = 1; o < 64; o <<= 1) s += __shfl_xor(s, o);
      ab[c] = s;
    }
    float mine = 0.f;
#pragma unroll
    for (int c = 0; c < 16; ++c) mine = (lane == c) ? ab[c] : mine;
    if (lane < 16) AB[(size_t)row * 16 + lane] = mine;
  }
}

DI void phase_inproj(const Params& p, int l, unsigned char* smem) {
  unsigned char* const WS_ = launder_ptr(p.ws);
  const int tid = opaque_tid(), lane = tid & 63, wv = tid >> 6, wm = wv >> 1, wn = wv & 1, l31 = lane & 31, h = lane >> 5;
  bfr* sA = (bfr*)smem; bfr* sB = sA + 128 * 72;
  const bfr* H = (const bfr*)(WS_ + O_H);
  const bfr* W = (const bfr*)(WS_ + O_WIN) + (size_t)l * NWIN * DM;
  bfr* P = (bfr*)(WS_ + O_P);
  float* AB = (float*)(WS_ + O_AB);
  bfr* FTL = (bfr*)(WS_ + O_FTL); bfr* FTC = (bfr*)(WS_ + O_FTC); bfr* VT = (bfr*)(WS_ + O_VT);
  const float* ROPE = (const float*)(WS_ + O_ROPE);
  for (int it = 0;; ++it) {
    int mt, nt;
    if (!tile_order_mfast(it, 136, 64, 34, 2, mt, nt)) break;
    if (mt < 0) continue;
    const int m0 = mt * 128, n0 = nt * 256;
    f32x16 acc[2][4];
    for (int i = 0; i < 2; ++i) for (int j = 0; j < 4; ++j) acc[i][j] = zero16();
    gemm_big(H + (size_t)m0 * 32, (size_t)NTOK * 32, W + (size_t)n0 * 32, (size_t)NWIN * 32, DM, acc, smem);
    const int b = m0 / SP, s0 = m0 - b * SP;
    const bool isctx = s0 < CTX;
#pragma unroll
    for (int mi = 0; mi < 2; ++mi)
#pragma unroll
      for (int ni = 0; ni < 4; ++ni) {
        const int cb = n0 + wn * 128 + ni * 32, col = cb + l31, rb = wm * 64 + mi * 32;
        const f32x16& a = acc[mi][ni];
        if (n0 < 1024) {
          const int part = n0 >> 9, ch = col & 511;
#pragma unroll
          for (int g = 0; g < 4; ++g) {
            const int rr = rb + 8 * g + 4 * h;
            u32x2 w; w[0] = pk2(a[4 * g], a[4 * g + 1]); w[1] = pk2(a[4 * g + 2], a[4 * g + 3]);
            if (isctx) *(u32x2*)(FTC + ((size_t)(b * 512 + ch)) * 512 + part * 256 + s0 + rr) = w;
            else *(u32x2*)(FTL + ((size_t)(b * 512 + ch)) * 8192 + part * 4096 + (s0 - CTX) + rr) = w;
          }
        } else if (n0 >= C_DAV && n0 < C_DAZ) {
          const int cc = col - C_DAV;
#pragma unroll
          for (int g = 0; g < 4; ++g) {
            const int rr = rb + 8 * g + 4 * h;
            u32x2 w; w[0] = pk2(a[4 * g], a[4 * g + 1]); w[1] = pk2(a[4 * g + 2], a[4 * g + 3]);
            *(u32x2*)(VT + ((size_t)(b * 512 + cc)) * SP + s0 + rr) = w;
          }
        } else if (n0 >= C_DAQ && n0 < C_DAV && !isctx) {
          const int aidx = ((cb >> 5) & 1) * 16 + (l31 & 15);
          const bool lo = (l31 & 16) == 0;
#pragma unroll
          for (int r = 0; r < 16; ++r) {
            const int rr = rb + crow(r, h), pos = s0 - CTX + rr;
            const float v = a[r], o = __shfl_xor(v, 16);
            const float cs = ROPE[((size_t)pos * 32 + aidx) * 2], sn = ROPE[((size_t)pos * 32 + aidx) * 2 + 1];
            const float res = lo ? v * cs - o * sn : v * cs + o * sn;
            P[(size_t)(m0 + rr) * PLD + col] = f2bf(res);
          }
        } else {
#pragma unroll
          for (int r = 0; r < 16; ++r) P[(size_t)(m0 + rb + crow(r, h)) * PLD + col] = f2bf(a[r]);
        }
      }
  }
}

DI void dft_tile(const Params& p, int t, unsigned char* smem) {
  unsigned char* const WS_ = launder_ptr(p.ws);
  const int tid = opaque_tid(), lane = tid & 63, wv = tid >> 6, wm = wv >> 1, wn = wv & 1, l31 = lane & 31, h = lane >> 5;
  bfr* sA = (bfr*)smem; bfr* sB = sA + 128 * 72;
  bfr* F = (bfr*)(WS_ + O_F);
  const bfr *A, *Bt; int lda, K, rowbase, nt;
  if (t < 512) {
    const int b = t >> 7, q = t & 127, mt = q >> 2; nt = q & 3;
    A = (const bfr*)(WS_ + O_DFTL) + (size_t)mt * 128 * 8192; lda = 8192; K = 8192;
    Bt = (const bfr*)(WS_ + O_FTL) + ((size_t)b * 512 + nt * 128) * 8192;
    rowbase = b * SP + CTX + mt * 128;
  } else {
    const int q = t - 512, b = q >> 3, mt = (q >> 2) & 1; nt = q & 3;
    A = (const bfr*)(WS_ + O_DFTC) + (size_t)mt * 128 * 512; lda = 512; K = 512;
    Bt = (const bfr*)(WS_ + O_FTC) + ((size_t)b * 512 + nt * 128) * 512;
    rowbase = b * SP + mt * 128;
  }
  f32x16 acc[2][2];
  for (int i = 0; i < 2; ++i) for (int j = 0; j < 2; ++j) acc[i][j] = zero16();
  gemm_main<2>(A, lda, Bt, lda, K, acc, sA, sB);
#pragma unroll
  for (int mi = 0; mi < 2; ++mi)
#pragma unroll
    for (int ni = 0; ni < 2; ++ni) {
      const int col = nt * 128 + wn * 64 + ni * 32 + l31, rb = rowbase + wm * 64 + mi * 32;
#pragma unroll
      for (int r = 0; r < 16; ++r) F[(size_t)(rb + crow(r, h)) * 512 + col] = f2bf(acc[mi][ni][r]);
    }
}

DI void fnw_tile(const Params& p, int l, int t, unsigned char* smem) {
  unsigned char* const WS_ = launder_ptr(p.ws);
  const int tid = opaque_tid(), lane = tid & 63, wv = tid >> 6, wm = wv >> 1, wn = wv & 1, l31 = lane & 31, h = lane >> 5;
  bfr* sA = (bfr*)smem; bfr* sB = sA + 128 * 72;
  const int mt = t >> 2, nt = t & 3, m0 = mt * 128, n0 = nt * 128;
  const bfr* F = (const bfr*)(WS_ + O_F);
  const bfr* W = (const bfr*)(WS_ + O_FNW) + (size_t)l * 512 * 512;
  const bfr* P = (const bfr*)(WS_ + O_P);
  bfr* YS = (bfr*)(WS_ + O_YS);
  f32x16 acc[2][2];
  for (int i = 0; i < 2; ++i) for (int j = 0; j < 2; ++j) acc[i][j] = zero16();
  gemm_main<2>(F + (size_t)m0 * 512, 512, W + (size_t)n0 * 512, 512, 512, acc, sA, sB);
#pragma unroll
  for (int mi = 0; mi < 2; ++mi)
#pragma unroll
    for (int ni = 0; ni < 2; ++ni) {
      const int col = n0 + wn * 64 + ni * 32 + l31, rb = m0 + wm * 64 + mi * 32;
      const float bias = p.fn_b[l * 512 + col];
#pragma unroll
      for (int r = 0; r < 16; ++r) {
        const size_t row = rb + crow(r, h);
        const float z = bf2f(P[row * PLD + C_FNZ + col]);
        YS[row * DM + col] = f2bf((acc[mi][ni][r] + bias) * siluf_(z));
      }
    }
}

DI void stream_of(int n, int cpc, int& m, int& T, int& soff) { if (n < cpc) { m = n; T = CTX; soff = 0; } else { m = n - cpc; T = SEQ; soff = CTX; } }

DI void dn_prep_unit(const Params& p, int l, int unit, unsigned char* smem) {
  unsigned char* const WS_ = launder_ptr(p.ws);
  const int tid = opaque_tid(), lane = tid & 63, wv = tid >> 6, l31 = lane & 31, h = lane >> 5;
  const int n = unit % 68, hd = (unit / 68) & 3, b = (unit / 272) & 3, dir = unit / 1088;
  int m, T, soff; stream_of(n, 4, m, T, soff);
  bfr* sK = (bfr*)smem;
  bfr* sQ = (bfr*)(smem + 17408);
  bfr* sVbT = (bfr*)(smem + 34816);
  bfr* sKbT = (bfr*)(smem + 53248);
  float* sgc = (float*)(smem + 71680);
  float* sbeta = sgc + 64;
  float* sAm = (float*)smem;
  bfr* sT = (bfr*)(smem + 17408);
  const bfr* P = (const bfr*)(WS_ + O_P);
  const float* AB = (const float*)(WS_ + O_AB);
  bfr* U = (bfr*)(WS_ + O_DNU) + (size_t)unit * DN_USZ;
  bfr* g_wneg = U; bfr* g_qdec = U + 8192; bfr* g_kdT = U + 16384; bfr* g_aqk = U + 24576; bfr* g_u = U + 28672;
  const int rowbase = b * SP + soff;
  __syncthreads();
  if (wv == 0) {
    const int pos = 64 * m + lane, t = dir ? T - 1 - pos : pos;
    const size_t row = rowbase + t;
    const float a = AB[row * 16 + dir * 4 + hd], bb = AB[row * 16 + 8 + dir * 4 + hd];
    const float xa = a + p.dn_dt_bias[(l * 2 + dir) * 4 + hd];
    const float sp = xa > 20.f ? xa : log1pf(__expf(xa));
    float g = -__expf(p.dn_a_log[(l * 2 + dir) * 4 + hd]) * sp;
#pragma unroll
    for (int o = 1; o < 64; o <<= 1) { const float u = __shfl_up(g, o); if (lane >= o) g += u; }
    sgc[lane] = g; sbeta[lane] = sigmoidf_(bb);
  }
  __syncthreads();
  {
    const int i = tid >> 2, cq = tid & 3;
    const int pos = 64 * m + i, t = dir ? T - 1 - pos : pos;
    const size_t row = rowbase + t;
    const float gci = sgc[i], bet = sbeta[i], gl = sgc[63];
    const float egc = __expf(gci), ekd = __expf(gl - gci);
    const bool hp = t > 0, hn = t < T - 1;
#pragma unroll
    for (int ten = 0; ten < 3; ++ten) {
      float val[32]; float ss = 0.f;
      const int cbase = ten * 512 + hd * 128 + cq * 32;
      const bfr* src = P + row * PLD + C_DNQ + cbase;
      const float* cw = p.dn_conv + (size_t)l * 3 * 1536 + cbase;
#pragma unroll
      for (int c8 = 0; c8 < 4; ++c8) {
        const bf16x8 cur = ld16(src + 8 * c8);
        bf16x8 prv, nxt;
        for (int j = 0; j < 8; ++j) { prv[j] = 0; nxt[j] = 0; }
        if (hp) prv = ld16(src - PLD + 8 * c8);
        if (hn) nxt = ld16(src + PLD + 8 * c8);
#pragma unroll
        for (int j = 0; j < 8; ++j) {
          const int ch = 8 * c8 + j;
          const float y = cw[ch] * bf2f((bfr)prv[j]) + cw[1536 + ch] * bf2f((bfr)cur[j]) + cw[3072 + ch] * bf2f((bfr)nxt[j]);
          const float sv = siluf_(y);
          val[ch] = sv; ss += sv * sv;
        }
      }
      ss += __shfl_xor(ss, 1); ss += __shfl_xor(ss, 2);
      if (ten == 0) {
        const float sc = rsqrtf(ss + EPS) * 0.08838834764831845f;
#pragma unroll
        for (int c8 = 0; c8 < 4; ++c8) {
          u32x4 w1, w2;
#pragma unroll
          for (int q = 0; q < 4; ++q) {
            const float x0 = val[8 * c8 + 2 * q] * sc, x1 = val[8 * c8 + 2 * q + 1] * sc;
            w1[q] = pk2(x0, x1); w2[q] = pk2(x0 * egc, x1 * egc);
          }
          *(u32x4*)(sQ + i * 136 + cq * 32 + 8 * c8) = w1;
          { u32x2 lo2, hi2; lo2[0] = w2[0]; lo2[1] = w2[1]; hi2[0] = w2[2]; hi2[1] = w2[3];
            *(u32x2*)(g_qdec + fragp_idx(i, cq * 32 + 8 * c8, 4)) = lo2;
            *(u32x2*)(g_qdec + fragp_idx(i, cq * 32 + 8 * c8 + 4, 4)) = hi2; }
        }
      } else if (ten == 1) {
        const float sc = rsqrtf(ss + EPS);
#pragma unroll
        for (int c8 = 0; c8 < 4; ++c8) {
          u32x4 w1;
#pragma unroll
          for (int q = 0; q < 4; ++q) w1[q] = pk2(val[8 * c8 + 2 * q] * sc, val[8 * c8 + 2 * q + 1] * sc);
          *(u32x4*)(sK + i * 136 + cq * 32 + 8 * c8) = w1;
        }
#pragma unroll
        for (int ch = 0; ch < 32; ++ch) {
          const float kn = val[ch] * sc;
          sKbT[(cq * 32 + ch) * 72 + i] = f2bf(kn * bet * egc);
          g_kdT[fragp_idx(cq * 32 + ch, i, 2)] = f2bf(kn * ekd);
        }
      } else {
#pragma unroll
        for (int ch = 0; ch < 32; ++ch) sVbT[(cq * 32 + ch) * 72 + i] = f2bf(val[ch] * bet);
      }
    }
    if (tid == 0) ((float*)(WS_ + O_DNG))[unit] = __expf(gl);
  }
  __syncthreads();
  f32x16 kk = zero16(), qk = zero16();
  const int qi = wv >> 1, qj = wv & 1;
#pragma unroll
  for (int s = 0; s < 8; ++s) {
    const bf16x8 bk = ld16(sK + (32 * qj + l31) * 136 + 16 * s + 8 * h);
    const bf16x8 ak = ld16(sK + (32 * qi + l31) * 136 + 16 * s + 8 * h);
    const bf16x8 aq = ld16(sQ + (32 * qi + l31) * 136 + 16 * s + 8 * h);
    kk = MFMA(ak, bk, kk); qk = MFMA(aq, bk, qk);
  }
  __syncthreads();
  {
    const int j = 32 * qj + l31;
    const float gcj = sgc[j];
#pragma unroll
    for (int r = 0; r < 16; ++r) {
      const int i = 32 * qi + crow(r, h);
      const float dec = i >= j ? __expf(sgc[i] - gcj) : 0.f;
      sAm[i * 65 + j] = i > j ? sbeta[i] * kk[r] * dec : 0.f;
      g_aqk[fragp_idx(i, j, 2)] = f2bf(i >= j ? qk[r] * dec : 0.f);
    }
  }
  __syncthreads();
  if (wv == 0) {
    float Tc[64];
#pragma unroll
    for (int i = 0; i < 64; ++i) {
      const float arow = sAm[i * 65 + lane];
      float a = (i == lane) ? 1.f : 0.f, a2 = 0.f;
#pragma unroll
      for (int j = 0; j < i; ++j) {
        const float av = __uint_as_float(__builtin_amdgcn_readlane(__float_as_uint(arow), j));
        if (j & 1) a2 -= av * Tc[j]; else a -= av * Tc[j];
      }
      Tc[i] = a + a2;
      __builtin_amdgcn_sched_barrier(0);
    }
#pragma unroll
    for (int i = 0; i < 64; ++i) sT[i * 72 + lane] = f2bf(Tc[i]);
  }
  __syncthreads();
#pragma unroll
  for (int q = 0; q < 4; ++q) {
    const int tt = wv * 4 + q, which = tt >> 3, mb = (tt >> 2) & 1, nb = tt & 3;
    const bfr* Bs = which ? sKbT : sVbT;
    f32x16 a = zero16();
#pragma unroll
    for (int s = 0; s < 4; ++s) a = MFMA(ld16(sT + (32 * mb + l31) * 72 + 16 * s + 8 * h), ld16(Bs + (32 * nb + l31) * 72 + 16 * s + 8 * h), a);
    if (which) {
#pragma unroll
      for (int r = 0; r < 16; ++r) g_wneg[fragp_idx(32 * mb + crow(r, h), 32 * nb + l31, 4)] = f2bf(-a[r]);
    } else {
      u32x4 w0, w1;
#pragma unroll
      for (int q2 = 0; q2 < 4; ++q2) { w0[q2] = pk2(a[2 * q2], a[2 * q2 + 1]); w1[q2] = pk2(a[8 + 2 * q2], a[8 + 2 * q2 + 1]); }
      bfr* d = g_u + ((mb * 4 + nb) * 64 + lane) * 16;
      *(u32x4*)d = w0; *(u32x4*)(d + 8) = w1;
    }
  }
}

DI void hg_prep_unit(const Params& p, int l, int unit, unsigned char* smem) {
  unsigned char* const WS_ = launder_ptr(p.ws);
  const int tid = opaque_tid(), lane = tid & 63, wv = tid >> 6, l31 = lane & 31, h = lane >> 5;
  const int n = unit % 136, hd = (unit / 136) & 3, b = (unit / 544) & 3, dir = unit / 2176;
  int m, T, soff; stream_of(n, 8, m, T, soff);
  bfr* sQt = (bfr*)smem;
  bfr* sKt = (bfr*)(smem + 8704);
  bfr* sVT = (bfr*)(smem + 17408);
  const bfr* P = (const bfr*)(WS_ + O_P);
  bfr* U = (bfr*)(WS_ + O_HGU) + (size_t)unit * HG_USZ;
  bfr* g_qhat = U; bfr* g_khT = U + 4096; bfr* g_vT = U + 8192;
  float* OHG = (float*)(WS_ + O_OHG) + (size_t)dir * NTOK * 512;
  const int rowbase = b * SP + soff;
  float* sTot = (float*)(smem + 27648);
  __syncthreads();
  {
    const int dk = tid & 127, hf = tid >> 7, i0 = 16 * hf;
    const float lbv = ((const float*)(WS_ + O_LB))[(l * 2 + dir) * 512 + hd * 128 + dk];
    float G[16], KK[16], Q[16];
    unsigned vv[8];
#pragma unroll
    for (int i = 0; i < 16; ++i) {
      const int pos = 32 * m + i0 + i, t = dir ? T - 1 - pos : pos;
      const size_t row = rowbase + t;
      KK[i] = bf2f(P[row * PLD + C_HGF + dir * 512 + hd * 128 + dk]);
      Q[i] = bf2f(P[row * PLD + C_HGQ + hd * 128 + dk]);
      const unsigned x = P[row * PLD + C_HGI + hd * 128 + dk];
      if (i & 1) vv[i >> 1] |= x << 16; else vv[i >> 1] = x;
    }
    float cum = 0.f;
#pragma unroll
    for (int i = 0; i < 16; ++i) {
      const float kkv = fminf((1.f - lbv) * sigmoidf_(-KK[i]), 0.9999999f);
      KK[i] = kkv;
      cum += log1pf(-kkv);
      G[i] = cum;
    }
    sTot[hf * 128 + dk] = cum;
#pragma unroll
    for (int q = 0; q < 2; ++q) {
      u32x4 w; w[0] = vv[4 * q]; w[1] = vv[4 * q + 1]; w[2] = vv[4 * q + 2]; w[3] = vv[4 * q + 3];
      *(u32x4*)(g_vT + fragn_idx(dk, i0 + 8 * q, 2)) = w;
      *(u32x4*)(sVT + dk * 40 + i0 + 8 * q) = w;
    }
    __syncthreads();
    const float t0 = sTot[dk], t1 = sTot[128 + dk];
    const float Gl = t0 + t1, Gr = t0, goff = hf ? t0 : 0.f;
    unsigned kh[8];
#pragma unroll
    for (int i = 0; i < 16; ++i) {
      const int ig = i0 + i;
      const float Gi = G[i] + goff;
      const float kkv = KK[i];
      const float q = siluf_(Q[i]);
      g_qhat[fragp_idx(ig, dk, 4)] = f2bf(q * __expf(Gi));
      const float khv = kkv * __expf(Gl - Gi);
      if (i & 1) kh[i >> 1] |= ((unsigned)f2bf(khv)) << 16; else kh[i >> 1] = f2bf(khv);
      sQt[ig * 136 + dk] = f2bf(q * __expf(fminf(Gi - Gr, 80.f)));
      sKt[ig * 136 + dk] = f2bf(kkv * __expf(fminf(Gr - Gi, 80.f)));
    }
#pragma unroll
    for (int q = 0; q < 2; ++q) { u32x4 w; w[0] = kh[4 * q]; w[1] = kh[4 * q + 1]; w[2] = kh[4 * q + 2]; w[3] = kh[4 * q + 3]; *(u32x4*)(g_khT + fragn_idx(dk, i0 + 8 * q, 2)) = w; }
    if (hf == 0) ((float*)(WS_ + O_HGD))[(size_t)unit * 128 + dk] = __expf(Gl);
  }
  __syncthreads();
  f32x16 at = zero16();
#pragma unroll
  for (int s = 0; s < 8; ++s) at = MFMA(ld16(sKt + l31 * 136 + 16 * s + 8 * h), ld16(sQt + l31 * 136 + 16 * s + 8 * h), at);
#pragma unroll
  for (int r = 0; r < 16; ++r) at[r] = (crow(r, h) <= l31) ? at[r] : 0.f;
  const bf16x8 a0 = pack8<0>(at), a1 = pack8<1>(at);
  f32x16 o = zero16();
  o = MFMA(ld2x8(sVT + (32 * wv + l31) * 40 + 4 * h), a0, o);
  o = MFMA(ld2x8(sVT + (32 * wv + l31) * 40 + 16 + 4 * h), a1, o);
  {
    const int pos = 32 * m + l31, t = dir ? T - 1 - pos : pos;
    float* dst = OHG + (size_t)(rowbase + t) * 512 + hd * 128 + 32 * wv + 4 * h;
#pragma unroll
    for (int g = 0; g < 4; ++g) { f32x4 w; w[0] = o[4 * g]; w[1] = o[4 * g + 1]; w[2] = o[4 * g + 2]; w[3] = o[4 * g + 3]; *(f32x4*)(dst + 8 * g) = w; }
  }
}

DI void unpack16(const bfr* p, f32x16& v) {
  const bf16x8 a = ld16(p), b = ld16(p + 8);
#pragma unroll
  for (int e = 0; e < 8; ++e) { v[e] = bf2f((bfr)a[e]); v[8 + e] = bf2f((bfr)b[e]); }
}
DI void dn_scan_block(const Params& p, int chain_in, unsigned char* smem) {
  int chain = blockIdx.x; asm volatile("" : "+v"(chain)); chain = __builtin_amdgcn_readfirstlane(chain) - chain_in;
  unsigned char* const WS_ = launder_ptr(p.ws);
  const int tid = opaque_tid(), lane = tid & 63, sl = tid >> 6, l31 = lane & 31, h = lane >> 5;
  const int hd = chain & 3, b = (chain >> 2) & 3, dir = chain >> 4;
  float* ODN = (float*)(WS_ + O_ODN) + (size_t)dir * NTOK * 512;
  const float* GL = (const float*)(WS_ + O_DNG);
  bfr* sU = (bfr*)smem;
  const bfr *s_wneg = sU, *s_qdec = sU + 8192, *s_kdT = sU + 16384, *s_aqk = sU + 24576, *s_u = sU + 28672;
  const u32x4* src = (const u32x4*)(WS_ + O_DNU) + (size_t)chain * 68 * 4608;
  u32x4 st[18];
#pragma unroll
  for (int i = 0; i < 18; ++i) st[i] = src[tid + 256 * i];
  f32x16 S[4];
  for (int i = 0; i < 4; ++i) S[i] = zero16();
#pragma unroll 1
  for (int n = 0; n < 68; ++n) {
    __syncthreads();
#pragma unroll
    for (int i = 0; i < 18; ++i) ((u32x4*)sU)[tid + 256 * i] = st[i];
    __syncthreads();
    if (n + 1 < 68) {
#pragma unroll
      for (int i = 0; i < 18; ++i) st[i] = src[(size_t)(n + 1) * 4608 + tid + 256 * i];
    }
    const float gl = GL[chain * 68 + n];
    int m, T, soff; stream_of(n, 4, m, T, soff);
    f32x16 vn[2];
#pragma unroll
    for (int mb = 0; mb < 2; ++mb) {
      unpack16(s_u + ((mb * 4 + sl) * 64 + lane) * 16, vn[mb]);
#pragma unroll
      for (int k = 0; k < 4; ++k) {
        vn[mb] = MFMA(ld16(s_wneg + (((mb * 4 + k) * 2 + 0) * 64 + lane) * 8), pack8<0>(S[k]), vn[mb]);
        vn[mb] = MFMA(ld16(s_wneg + (((mb * 4 + k) * 2 + 1) * 64 + lane) * 8), pack8<1>(S[k]), vn[mb]);
      }
    }
    __builtin_amdgcn_sched_barrier(0);
    bf16x8 vp[2][2];
#pragma unroll
    for (int jb = 0; jb < 2; ++jb) { vp[jb][0] = pack8<0>(vn[jb]); vp[jb][1] = pack8<1>(vn[jb]); }
    __builtin_amdgcn_sched_barrier(0);
#pragma unroll
    for (int mb = 0; mb < 2; ++mb) {
      f32x16 o = zero16();
#pragma unroll
      for (int k = 0; k < 4; ++k) {
        o = MFMA(ld16(s_qdec + (((mb * 4 + k) * 2 + 0) * 64 + lane) * 8), pack8<0>(S[k]), o);
        o = MFMA(ld16(s_qdec + (((mb * 4 + k) * 2 + 1) * 64 + lane) * 8), pack8<1>(S[k]), o);
      }
#pragma unroll
      for (int jb = 0; jb < 2; ++jb)
#pragma unroll
        for (int s = 0; s < 2; ++s) o = MFMA(ld16(s_aqk + (((mb * 2 + jb) * 2 + s) * 64 + lane) * 8), vp[jb][s], o);
#pragma unroll
      for (int r = 0; r < 16; ++r) {
        const int pos = 64 * m + 32 * mb + crow(r, h), t = dir ? T - 1 - pos : pos;
        ODN[(size_t)(b * SP + soff + t) * 512 + hd * 128 + 32 * sl + l31] = o[r];
      }
      __builtin_amdgcn_sched_barrier(0);
    }
#pragma unroll
    for (int k = 0; k < 4; ++k) {
#pragma unroll
      for (int r = 0; r < 16; ++r) S[k][r] *= gl;
#pragma unroll
      for (int jb = 0; jb < 2; ++jb)
#pragma unroll
        for (int s = 0; s < 2; ++s) S[k] = MFMA(ld16(s_kdT + (((k * 2 + jb) * 2 + s) * 64 + lane) * 8), vp[jb][s], S[k]);
    }
  }
}

DI void hg_scan_block(const Params& p, int chain_in, unsigned char* smem) {
  int chain = blockIdx.x; asm volatile("" : "+v"(chain)); chain = __builtin_amdgcn_readfirstlane(chain) - chain_in;
  unsigned char* const WS_ = launder_ptr(p.ws);
  const int tid = opaque_tid(), lane = tid & 63, sl = tid >> 6, l31 = lane & 31, h = lane >> 5;
  const int hd = chain & 3, b = (chain >> 2) & 3, dir = chain >> 4;
  float* OHG = (float*)(WS_ + O_OHG) + (size_t)dir * NTOK * 512;
  bfr* sU = (bfr*)smem;
  const bfr *s_qhat = sU, *s_khT = sU + 4096, *s_vT = sU + 8192;
  float* s_ds = (float*)(smem + 24576);
  const u32x4* src = (const u32x4*)(WS_ + O_HGU) + (size_t)chain * 136 * 1536;
  const float* dsg = (const float*)(WS_ + O_HGD) + (size_t)chain * 136 * 128;
  u32x4 st[6]; float dsr;
#pragma unroll
  for (int i = 0; i < 6; ++i) st[i] = src[tid + 256 * i];
  dsr = dsg[tid & 127];
  float oc[16];
  {
    int m0_, T0_, so0_; stream_of(0, 8, m0_, T0_, so0_);
#pragma unroll
    for (int r = 0; r < 16; ++r) {
      const int pos = 32 * m0_ + crow(r, h), t = dir ? T0_ - 1 - pos : pos;
      oc[r] = OHG[(size_t)(b * SP + so0_ + t) * 512 + hd * 128 + 32 * sl + l31];
    }
  }
  f32x16 S[4];
  for (int i = 0; i < 4; ++i) S[i] = zero16();
#pragma unroll 1
  for (int n = 0; n < 136; ++n) {
    __syncthreads();
#pragma unroll
    for (int i = 0; i < 6; ++i) ((u32x4*)sU)[tid + 256 * i] = st[i];
    if (tid < 128) s_ds[tid] = dsr;
    __syncthreads();
    if (n + 1 < 136) {
#pragma unroll
      for (int i = 0; i < 6; ++i) st[i] = src[(size_t)(n + 1) * 1536 + tid + 256 * i];
      dsr = dsg[(size_t)(n + 1) * 128 + (tid & 127)];
    }
    float on[16];
    if (n + 1 < 136) {
      int m1_, T1_, so1_; stream_of(n + 1, 8, m1_, T1_, so1_);
#pragma unroll
      for (int r = 0; r < 16; ++r) {
        const int pos = 32 * m1_ + crow(r, h), t = dir ? T1_ - 1 - pos : pos;
        on[r] = OHG[(size_t)(b * SP + so1_ + t) * 512 + hd * 128 + 32 * sl + l31];
      }
    } else {
#pragma unroll
      for (int r = 0; r < 16; ++r) on[r] = 0.f;
    }
    int m, T, soff; stream_of(n, 8, m, T, soff);
    f32x16 o = zero16();
#pragma unroll
    for (int k = 0; k < 4; ++k) {
      o = MFMA(ld16(s_qhat + ((k * 2 + 0) * 64 + lane) * 8), pack8<0>(S[k]), o);
      o = MFMA(ld16(s_qhat + ((k * 2 + 1) * 64 + lane) * 8), pack8<1>(S[k]), o);
    }
#pragma unroll
    for (int r = 0; r < 16; ++r) {
      const int pos = 32 * m + crow(r, h), t = dir ? T - 1 - pos : pos;
      float* dst = OHG + (size_t)(b * SP + soff + t) * 512 + hd * 128 + 32 * sl + l31;
      *dst = oc[r] + o[r];
    }
    const bf16x8 v0 = ld16(s_vT + ((sl * 2 + 0) * 64 + lane) * 8), v1 = ld16(s_vT + ((sl * 2 + 1) * 64 + lane) * 8);
#pragma unroll
    for (int k = 0; k < 4; ++k) {
#pragma unroll
      for (int g = 0; g < 4; ++g) {
        const f32x4 d4 = *(const f32x4*)(s_ds + 32 * k + 8 * g + 4 * h);
        S[k][4 * g] *= d4[0]; S[k][4 * g + 1] *= d4[1]; S[k][4 * g + 2] *= d4[2]; S[k][4 * g + 3] *= d4[3];
      }
      S[k] = MFMA(ld16(s_khT + ((k * 2 + 0) * 64 + lane) * 8), v0, S[k]);
      S[k] = MFMA(ld16(s_khT + ((k * 2 + 1) * 64 + lane) * 8), v1, S[k]);
    }
#pragma unroll
    for (int r = 0; r < 16; ++r) oc[r] = on[r];
  }
}

DI void attn_unit(const Params& p, int l, int unit, unsigned char* smem) {
  unsigned char* const WS_ = launder_ptr(p.ws);
  const int tid = opaque_tid(), lane = tid & 63, wv = tid >> 6, l31 = lane & 31, h = lane >> 5;
  int b, hd, q0, nkeys;
  if (unit < 512) { b = unit >> 7; hd = (unit >> 5) & 3; q0 = CTX + (unit & 31) * 128; nkeys = SP; }
  else { const int u = unit - 512; b = u >> 3; hd = (u >> 1) & 3; q0 = (u & 1) * 128; nkeys = CTX; }
  bfr* sK = (bfr*)smem;
  bfr* sVT = (bfr*)(smem + 17408);
  const bfr* P = (const bfr*)(WS_ + O_P);
  const bfr* VT = (const bfr*)(WS_ + O_VT) + ((size_t)(b * 4 + hd) * 128) * SP;
  const float lam = ((const float*)(WS_ + O_LAM))[l];
  const float lam_init = 0.8f - 0.6f * expf(-0.3f * (float)l);
  const float cs = 0.125f * 1.4426950408889634f;
  const size_t rowq = (size_t)b * SP + q0 + wv * 32 + l31;
  bf16x8 qf[2][4];
#pragma unroll
  for (int mp = 0; mp < 2; ++mp)
#pragma unroll
    for (int s = 0; s < 4; ++s) qf[mp][s] = ld16(P + rowq * PLD + C_DAQ + hd * 128 + mp * 64 + 16 * s + 8 * h);
  const bfr* Kbase = P + (size_t)b * SP * PLD + C_DAK + hd * 128;
  float mx[2] = {-1e30f, -1e30f}, ls[2] = {0.f, 0.f};
  const int ntile = nkeys >> 6;
  u32x4 rk[4], rv[4];
#pragma unroll
  for (int i = 0; i < 4; ++i) { const int c = tid + 256 * i, key = c >> 4, kc = c & 15; rk[i] = *(const u32x4*)(Kbase + (size_t)key * PLD + 8 * kc); }
  for (int kt = 0; kt < ntile; ++kt) {
    __syncthreads();
#pragma unroll
    for (int i = 0; i < 4; ++i) { const int c = tid + 256 * i, key = c >> 4, kc = c & 15; *(u32x4*)(sK + key * 136 + 8 * kc) = rk[i]; }
    __syncthreads();
    if (kt + 1 < ntile) {
#pragma unroll
      for (int i = 0; i < 4; ++i) { const int c = tid + 256 * i, key = c >> 4, kc = c & 15; rk[i] = *(const u32x4*)(Kbase + (size_t)((kt + 1) * 64 + key) * PLD + 8 * kc); }
    }
#pragma unroll
    for (int kb = 0; kb < 2; ++kb)
#pragma unroll
      for (int mp = 0; mp < 2; ++mp) {
        f32x16 st = zero16();
#pragma unroll
        for (int s = 0; s < 4; ++s) st = MFMA(ld16(sK + (32 * kb + l31) * 136 + mp * 64 + 16 * s + 8 * h), qf[mp][s], st);
        float tm = st[0];
#pragma unroll
        for (int r = 1; r < 16; ++r) tm = fmaxf(tm, st[r]);
        const float mn = fmaxf(mx[mp], tm);
        const float nmc = -mn * cs;
        float sum = 0.f;
#pragma unroll
        for (int r = 0; r < 16; ++r) sum += __builtin_amdgcn_exp2f(fmaf(st[r], cs, nmc));
        ls[mp] = ls[mp] * __builtin_amdgcn_exp2f((mx[mp] - mn) * cs) + sum;
        mx[mp] = mn;
      }
  }
  float nm[2], sc[2];
#pragma unroll
  for (int mp = 0; mp < 2; ++mp) {
    const float mo = __shfl_xor(mx[mp], 32), lo = __shfl_xor(ls[mp], 32);
    const float M = fmaxf(mx[mp], mo);
    const float L = ls[mp] * __builtin_amdgcn_exp2f((mx[mp] - M) * cs) + lo * __builtin_amdgcn_exp2f((mo - M) * cs);
    nm[mp] = -M * cs; sc[mp] = (mp ? lam : 1.f) / L;
  }
  f32x16 oacc[4];
  for (int i = 0; i < 4; ++i) oacc[i] = zero16();
#pragma unroll
  for (int i = 0; i < 4; ++i) {
    const int c = tid + 256 * i;
    { const int key = c >> 4, kc = c & 15; rk[i] = *(const u32x4*)(Kbase + (size_t)key * PLD + 8 * kc); }
    { const int dv = c >> 3, kc = c & 7; rv[i] = *(const u32x4*)(VT + (size_t)dv * SP + 8 * kc); }
  }
  for (int kt = 0; kt < ntile; ++kt) {
    __syncthreads();
#pragma unroll
    for (int i = 0; i < 4; ++i) {
      const int c = tid + 256 * i;
      { const int key = c >> 4, kc = c & 15; *(u32x4*)(sK + key * 136 + 8 * kc) = rk[i]; }
      { const int dv = c >> 3, kc = c & 7; *(u32x4*)(sVT + dv * 72 + 8 * kc) = rv[i]; }
    }
    __syncthreads();
    if (kt + 1 < ntile) {
#pragma unroll
      for (int i = 0; i < 4; ++i) {
        const int c = tid + 256 * i;
        { const int key = c >> 4, kc = c & 15; rk[i] = *(const u32x4*)(Kbase + (size_t)((kt + 1) * 64 + key) * PLD + 8 * kc); }
        { const int dv = c >> 3, kc = c & 7; rv[i] = *(const u32x4*)(VT + (size_t)dv * SP + (kt + 1) * 64 + 8 * kc); }
      }
    }
#pragma unroll
    for (int kb = 0; kb < 2; ++kb) {
      f32x16 s0 = zero16(), s1 = zero16();
#pragma unroll
      for (int s = 0; s < 4; ++s) {
        s0 = MFMA(ld16(sK + (32 * kb + l31) * 136 + 16 * s + 8 * h), qf[0][s], s0);
        s1 = MFMA(ld16(sK + (32 * kb + l31) * 136 + 64 + 16 * s + 8 * h), qf[1][s], s1);
      }
#pragma unroll
      for (int r = 0; r < 16; ++r) s0[r] = __builtin_amdgcn_exp2f(fmaf(s0[r], cs, nm[0])) * sc[0] - __builtin_amdgcn_exp2f(fmaf(s1[r], cs, nm[1])) * sc[1];
      const bf16x8 p0 = pack8<0>(s0), p1 = pack8<1>(s0);
#pragma unroll
      for (int dvb = 0; dvb < 4; ++dvb) {
        oacc[dvb] = MFMA(ld2x8(sVT + (32 * dvb + l31) * 72 + 32 * kb + 4 * h), p0, oacc[dvb]);
        oacc[dvb] = MFMA(ld2x8(sVT + (32 * dvb + l31) * 72 + 32 * kb + 16 + 4 * h), p1, oacc[dvb]);
      }
    }
  }
  float ss = 0.f;
#pragma unroll
  for (int dvb = 0; dvb < 4; ++dvb)
#pragma unroll
    for (int r = 0; r < 16; ++r) ss += oacc[dvb][r] * oacc[dvb][r];
  ss += __shfl_xor(ss, 32);
  const float rs = rsqrtf(ss * (1.f / 128.f) + EPS) * (1.f - lam_init);
  bfr* YS = (bfr*)(WS_ + O_YS);
#pragma unroll
  for (int dvb = 0; dvb < 4; ++dvb)
#pragma unroll
    for (int g = 0; g < 4; ++g) {
      const int dv = 32 * dvb + 8 * g + 4 * h;
      const s16x4 z4 = *(const s16x4*)(P + rowq * PLD + C_DAZ + hd * 128 + dv);
      const f32x4 gn = *(const f32x4*)(p.da_norm + l * 128 + dv);
      float y[4];
      for (int q = 0; q < 4; ++q) y[q] = oacc[dvb][4 * g + q] * rs * gn[q] * siluf_(bf2f((bfr)z4[q]));
      u32x2 w; w[0] = pk2(y[0], y[1]); w[1] = pk2(y[2], y[3]);
      *(u32x2*)(YS + rowq * DM + 1536 + hd * 128 + dv) = w;
    }
}

DI void phase_finalize(const Params& p, int l) {
  unsigned char* const WS_ = launder_ptr(p.ws);
  const int tid_ = opaque_tid(), lane = tid_ & 63, gw = blockIdx.x * 4 + (tid_ >> 6), nw = gridDim.x * 4;
  const bfr* P = (const bfr*)(WS_ + O_P);
  bfr* YS = (bfr*)(WS_ + O_YS);
  for (int it = gw; it < 2 * NTOK; it += nw) {
    const int br = it & 1; const size_t row = it >> 1;
    const float* O0 = (const float*)(WS_ + (br ? O_OHG : O_ODN)) + row * 512 + lane * 8;
    const float* O1 = O0 + (size_t)NTOK * 512;
    const float* nrm = (br ? p.hg_norm : p.dn_norm) + l * 128 + (lane & 15) * 8;
    const int zc = (br ? C_HGZ : C_DNZ) + lane * 8;
    float o[8]; float ss = 0.f;
    const f32x4 a0 = *(const f32x4*)O0, a1 = *(const f32x4*)(O0 + 4), b0 = *(const f32x4*)O1, b1 = *(const f32x4*)(O1 + 4);
    for (int q = 0; q < 4; ++q) { o[q] = a0[q] + b0[q]; o[4 + q] = a1[q] + b1[q]; }
    for (int q = 0; q < 8; ++q) ss += o[q] * o[q];
    ss += __shfl_xor(ss, 1); ss += __shfl_xor(ss, 2); ss += __shfl_xor(ss, 4); ss += __shfl_xor(ss, 8);
    const float rs = rsqrtf(ss * (1.f / 128.f) + EPS);
    const bf16x8 z = ld16(P + row * PLD + zc);
    u32x4 w;
    for (int q = 0; q < 4; ++q) {
      const float y0 = o[2 * q] * rs * nrm[2 * q] * siluf_(bf2f((bfr)z[2 * q]));
      const float y1 = o[2 * q + 1] * rs * nrm[2 * q + 1] * siluf_(bf2f((bfr)z[2 * q + 1]));
      w[q] = pk2(y0, y1);
    }
    *(u32x4*)(YS + row * DM + (br ? 1024 : 512) + lane * 8) = w;
  }
}

DI void phase_merge(const Params& p, int l, unsigned char* smem) {
  unsigned char* const WS_ = launder_ptr(p.ws);
  const int tid = opaque_tid(), lane = tid & 63, wv = tid >> 6, wm = wv >> 1, wn = wv & 1, l31 = lane & 31, h = lane >> 5;
  bfr* sA = (bfr*)smem; bfr* sB = sA + 128 * 72;
  const bfr* YS = (const bfr*)(WS_ + O_YS);
  const bfr* P = (const bfr*)(WS_ + O_P);
  bfr* Y = (bfr*)(WS_ + O_Y);
  for (int it = 0;; ++it) {
    int mt, nt;
    if (!tile_order(it, 136, 16, 34, 4, mt, nt)) break;
    const int m0 = mt * 128, n0 = nt * 128;
    if (l == 3 && (m0 % SP) < CTX) continue;
    f32x16 tot[2][2];
    for (int i = 0; i < 2; ++i) for (int j = 0; j < 2; ++j) tot[i][j] = zero16();
#pragma unroll 1
    for (int nb = 0; nb < 4; ++nb) {
      f32x16 acc[2][2];
      for (int i = 0; i < 2; ++i) for (int j = 0; j < 2; ++j) acc[i][j] = zero16();
      gemm_main<2>(YS + (size_t)m0 * DM + nb * 512, DM, (const bfr*)(WS_ + O_WBR) + ((size_t)(l * 4 + nb) * 2048 + n0) * 512, 512, 512, acc, sA, sB);
#pragma unroll
      for (int mi = 0; mi < 2; ++mi)
#pragma unroll
        for (int ni = 0; ni < 2; ++ni) {
          int rbo = m0 + wm * 64 + mi * 32 + 4 * h;
          asm volatile("" : "+v"(rbo));
          const bfr* gp = P + (size_t)rbo * PLD + C_GATE + nb * 2048 + n0 + wn * 64 + ni * 32 + l31;
#pragma unroll
          for (int r = 0; r < 16; ++r) {
            const float g = bf2f(gp[(size_t)((r & 3) + 8 * (r >> 2)) * PLD]);
            tot[mi][ni][r] += sigmoidf_(g) * acc[mi][ni][r];
          }
          __builtin_amdgcn_sched_barrier(0);
        }
    }
#pragma unroll
    for (int mi = 0; mi < 2; ++mi)
#pragma unroll
      for (int ni = 0; ni < 2; ++ni) {
        const int col = n0 + wn * 64 + ni * 32 + l31, rb = m0 + wm * 64 + mi * 32;
#pragma unroll
        for (int r = 0; r < 16; ++r) Y[(size_t)(rb + crow(r, h)) * DM + col] = f2bf(tot[mi][ni][r]);
      }
  }
}

DI void phase_out(const Params& p, int l, unsigned char* smem) {
  unsigned char* const WS_ = launder_ptr(p.ws);
  const int tid = opaque_tid(), lane = tid & 63, wv = tid >> 6, wm = wv >> 1, wn = wv & 1, l31 = lane & 31, h = lane >> 5;
  bfr* sA = (bfr*)smem; bfr* sB = sA + 128 * 72;
  const bfr* Y = (const bfr*)(WS_ + O_Y);
  float* X = (float*)(WS_ + O_X);
  for (int it = 0;; ++it) {
    int mt, nt;
    if (!tile_order(it, 136, 16, 34, 4, mt, nt)) break;
    if (mt < 0) continue;
    const int m0 = mt * 128, n0 = nt * 128;
    if (l == 3 && (m0 % SP) < CTX) continue;
    f32x16 acc[2][2];
    for (int i = 0; i < 2; ++i) for (int j = 0; j < 2; ++j) acc[i][j] = zero16();
    gemm_main<2>(Y + (size_t)m0 * DM, DM, (const bfr*)(WS_ + O_WOUT) + ((size_t)l * 2048 + n0) * 2048, 2048, 2048, acc, sA, sB);
    const float* M = (const float*)(WS_ + O_MODS) + ((size_t)l * 5 + mod_vec(m0)) * 6144 + 4096;
#pragma unroll
    for (int mi = 0; mi < 2; ++mi)
#pragma unroll
      for (int ni = 0; ni < 2; ++ni) {
        const int col = n0 + wn * 64 + ni * 32 + l31, rb = m0 + wm * 64 + mi * 32;
        const float gt = M[col];
#pragma unroll
        for (int r = 0; r < 16; ++r) { float* d = X + (size_t)(rb + crow(r, h)) * DM + col; *d = *d + gt * acc[mi][ni][r]; }
      }
  }
}

DI void phase_final(const Params& p) {
  unsigned char* const WS_ = launder_ptr(p.ws);
  const int tid_ = opaque_tid(), lane = tid_ & 63, gw = blockIdx.x * 4 + (tid_ >> 6), nw = gridDim.x * 4;
  const float* X = (const float*)(WS_ + O_X);
  for (int r = gw; r < NB * SEQ; r += nw) {
    const int b = r >> 12, t = r & 4095;
    const f32x4* xr = (const f32x4*)(X + ((size_t)b * SP + CTX + t) * DM);
    f32x4 v[8]; float ss = 0.f;
#pragma unroll
    for (int j = 0; j < 8; ++j) { v[j] = xr[lane + 64 * j]; ss += v[j][0] * v[j][0] + v[j][1] * v[j][1] + v[j][2] * v[j][2] + v[j][3] * v[j][3]; }
#pragma unroll
    for (int o = 1; o < 64; o <<= 1) ss += __shfl_xor(ss, o);
    const float rs = rsqrtf(ss * (1.f / DM) + EPS);
    f32x4* dst = (f32x4*)(p.out + (size_t)r * DM);
#pragma unroll
    for (int j = 0; j < 8; ++j) {
      const f32x4 g = *(const f32x4*)(p.final_g + 4 * (lane + 64 * j));
      f32x4 o; for (int q = 0; q < 4; ++q) o[q] = v[j][q] * rs * g[q];
      dst[lane + 64 * j] = o;
    }
  }
}

DI void gbar(unsigned char* ws, unsigned& epoch) {
  __syncthreads();
  if (threadIdx.x == 0) {
    unsigned* bar = (unsigned*)(ws + O_BAR);
    epoch += 1;
    __builtin_amdgcn_fence(__ATOMIC_RELEASE, "agent");
    asm volatile("s_waitcnt vmcnt(0)" ::: "memory");
    const unsigned g = blockIdx.x & 7, ng = (gridDim.x + 7 - g) >> 3;
    const unsigned prev = __hip_atomic_fetch_add(bar + 64 * g, 1u, __ATOMIC_RELAXED, __HIP_MEMORY_SCOPE_AGENT);
    if (prev + 1 == ng * epoch) {
      const unsigned pt = __hip_atomic_fetch_add(bar + 64 * 16, 1u, __ATOMIC_RELAXED, __HIP_MEMORY_SCOPE_AGENT);
      if (pt + 1 == 8 * epoch) {
        for (int j = 0; j < 8; ++j) __hip_atomic_store(bar + 64 * (8 + j), epoch, __ATOMIC_RELAXED, __HIP_MEMORY_SCOPE_AGENT);
      }
    }
    while (__hip_atomic_load(bar + 64 * (8 + g), __ATOMIC_RELAXED, __HIP_MEMORY_SCOPE_AGENT) < epoch) __builtin_amdgcn_s_sleep(1);
    __builtin_amdgcn_fence(__ATOMIC_ACQUIRE, "agent");
    asm volatile("s_waitcnt vmcnt(0)" ::: "memory");
  }
  __syncthreads();
}

__global__ void __launch_bounds__(256, 2) mega(Params p) {
  cg::grid_group grid = cg::this_grid();
  __shared__ __attribute__((aligned(16))) unsigned char smem[SMEM_BYTES];
  __shared__ int s_item;
  phase0(p, smem);
  grid.sync();
  unsigned epoch = 0;
#pragma unroll 1
  for (int l = 0; l < 4; ++l) {
    phase_adaln(p, l, smem);
    gbar(p.ws, epoch);
    phase_inproj(p, l, smem);
    gbar(p.ws, epoch);
    {
      constexpr int N_DFT = 544, N_DN = DN_UNITS, N_HG = HG_UNITS;
      const int tid = opaque_tid();
      unsigned* ctr3 = (unsigned*)(p.ws + O_CTR) + 8 + l;
      const int n_att3 = (l < 3) ? 96 : 64;
      if (gridDim.x == 512) {
        const int xcd = blockIdx.x & 7, local = blockIdx.x >> 3;
        const int mt = (xcd & 3) * 8 + (local >> 3), nn = (xcd >> 2) * 8 + (local & 7);
        dft_tile(p, (nn >> 2) * 128 + mt * 4 + (nn & 3), smem);
      }
      const int dft0 = (gridDim.x == 512) ? 512 : 0;
      for (;;) {
        __syncthreads();
        if (tid == 0) s_item = (int)atomicAdd(ctr3, 1u);
        __syncthreads();
        const int it = s_item - n_att3 + dft0;
        if (it >= N_DFT + N_DN + N_HG) break;
        if (it < dft0) attn_unit(p, l, 448 + (it - dft0) + n_att3, smem);
        else if (it < N_DFT) dft_tile(p, it, smem);
        else if (it < N_DFT + N_DN) dn_prep_unit(p, l, it - N_DFT, smem);
        else hg_prep_unit(p, l, it - N_DFT - N_DN, smem);
      }
    }
    gbar(p.ws, epoch);
    {
      const int tid = opaque_tid();
      if (blockIdx.x < 32) dn_scan_block(p, 0, smem);
      else if (blockIdx.x < 64) hg_scan_block(p, 32, smem);
      unsigned* ctr = (unsigned*)(p.ws + O_CTR) + l;
      const int n_attn = 448;
      for (;;) {
        __syncthreads();
        if (tid == 0) s_item = (int)atomicAdd(ctr, 1u);
        __syncthreads();
        const int item = s_item;
        if (item >= n_attn + 544) break;
        if (item < n_attn) attn_unit(p, l, item, smem); else fnw_tile(p, l, item - n_attn, smem);
      }
    }
    gbar(p.ws, epoch);
    phase_finalize(p, l);
    gbar(p.ws, epoch);
    phase_merge(p, l, smem);
    gbar(p.ws, epoch);
    phase_out(p, l, smem);
    gbar(p.ws, epoch);
  }
  phase_final(p);
}

extern "C" void kernel_launch(void* const* d_in, const int* in_sizes, int n_in, void* d_out, int out_size, void* d_ws, size_t ws_size,
                              hipStream_t stream) {
  static int grid_blocks = 0;
  if (!grid_blocks) {
    int dev = 0, cus = 0, per_cu = 0;
    hipGetDevice(&dev);
    hipDeviceGetAttribute(&cus, hipDeviceAttributeMultiprocessorCount, dev);
    hipOccupancyMaxActiveBlocksPerMultiprocessor(&per_cu, (const void*)mega, 256, 0);
    if (per_cu < 1) per_cu = 1;
    if (per_cu > 2) per_cu = 2;
    grid_blocks = cus * per_cu;
    if (ws_size < O_END) fprintf(stderr, "workspace too small: %zu < %zu\n", ws_size, (size_t)O_END);
  }
  Params p{};
  const float** f = (const float**)&p;
  for (int i = 0; i < 21; ++i) f[i] = (const float*)d_in[i];
  p.out = (float*)d_out;
  p.ws = (unsigned char*)d_ws;
  void* args[] = {&p};
  hipError_t e = hipLaunchCooperativeKernel((const void*)mega, dim3(grid_blocks), dim3(256), args, 0, stream);
  if (e != hipSuccess) fprintf(stderr, "cooperative launch failed: %s (grid %d)\n", hipGetErrorString(e), grid_blocks);
}
```
